# Optimizing an MI355X kernel written in HIP

```python
import math
import jax
import jax.numpy as jnp
from jax import lax
import numpy as np

D_MODEL = 2048
BATCH = 4
SEQ = 2048
DEPTH = 2

N_META = 16
CHUNK = 64
HG_CHUNK = 16
LEAD_PAD = CHUNK - N_META
EPS = 1e-6
NEG = -1e30
LB_FLOOR = 1e-30

HG_HEADS = 4
HG_KDIM = 128
HG_VDIM = 128
HG_KEY = HG_HEADS * HG_KDIM
HG_WIDTH = HG_HEADS * HG_VDIM

ML_HEADS = 4
ML_QK = 64
ML_V = 128
ML_QK_W = ML_HEADS * ML_QK
ML_WIDTH = ML_HEADS * ML_V
GATE_CAP = 15.0

SSM_HEADS = 16
SSM_HEADDIM = 64
SSM_WIDTH = SSM_HEADS * SSM_HEADDIM
SSM_STATE = 128
SSM_GROUPS = 4
SSM_BC = SSM_GROUPS * SSM_STATE
CONV_W = 4
CONV_CH = SSM_WIDTH + 2 * SSM_BC

D_MIX = HG_WIDTH + ML_WIDTH + SSM_WIDTH
IN_SPLITS = (HG_KEY, HG_KEY, HG_WIDTH, HG_WIDTH,
             ML_QK_W, ML_QK_W, ML_WIDTH, ML_WIDTH, ML_HEADS, ML_HEADS,
             SSM_WIDTH, CONV_CH, SSM_HEADS)
D_IN = sum(IN_SPLITS)

N_GROUPS_MOE = 4
EXPERTS_PER_GROUP = 8
N_EXPERTS = N_GROUPS_MOE * EXPERTS_PER_GROUP
TOP_K = 2
D_EXPERT = 512
MOE_BLOCK = 128

kernel_name = 'hymba_hgrn2_mlstm_ssd_hmoe'


def rmsnorm(x, w):
    xf = x.astype(jnp.float32)
    y = xf * lax.rsqrt(jnp.mean(xf * xf, axis=-1, keepdims=True) + EPS)
    return (y * w.astype(jnp.float32)).astype(x.dtype)


def group_rmsnorm(y, w, groups):
    shape = y.shape
    yg = y.reshape(shape[:-1] + (groups, shape[-1] // groups))
    yg = yg * lax.rsqrt(jnp.mean(yg * yg, axis=-1, keepdims=True) + EPS)
    return yg.reshape(shape) * w


def softcap(t):
    return GATE_CAP * jnp.tanh(t / GATE_CAP)


def split_last(t, sizes):
    offsets = [int(o) for o in np.cumsum(sizes)[:-1]]
    return jnp.split(t, offsets, axis=-1)


def lead_pad(t, value=0.0):
    widths = [(0, 0)] * t.ndim
    widths[1] = (LEAD_PAD, 0)
    return jnp.pad(t, widths, constant_values=value)


def causal_mask(c):
    return jnp.tril(jnp.ones((c, c), dtype=bool))


def carry_linear_state(decay, local):
    def step(s, inp):
        a, u = inp
        return a * s + u, s
    _, prev = lax.scan(step, jnp.zeros_like(local[0]), (decay, local))
    return prev


def hgrn2_mixer(q, f_logit, inp, g, lower_bound, norm_w):
    b = q.shape[0]
    log_lb = jnp.log(jnp.maximum(lower_bound, LB_FLOOR))
    log_f = jnp.logaddexp(log_lb, jnp.log1p(-lower_bound) + jax.nn.log_sigmoid(f_logit))
    q = lead_pad(q * HG_KDIM ** -0.5)
    log_f = lead_pad(log_f)
    v = lead_pad(inp)
    k = -jnp.expm1(log_f)
    p = q.shape[1]
    nc = p // HG_CHUNK

    def chunks(t, dim):
        return t.reshape(b, nc, HG_CHUNK, HG_HEADS, dim).transpose(0, 3, 1, 2, 4)

    q, k, log_f, v = chunks(q, HG_KDIM), chunks(k, HG_KDIM), chunks(log_f, HG_KDIM), chunks(v, HG_VDIM)
    cum = jnp.cumsum(log_f, axis=3)
    rel = jnp.where(causal_mask(HG_CHUNK)[:, :, None],
                    cum[..., :, None, :] - cum[..., None, :, :], NEG)
    scores = jnp.einsum('bhntd,bhnsd,bhntsd->bhnts', q, k, jnp.exp(rel))
    o_intra = jnp.einsum('bhnts,bhnsv->bhntv', scores, v)
    last = cum[..., -1:, :]
    local = jnp.einsum('bhnsd,bhnsv->bhndv', k * jnp.exp(last - cum), v)
    decay = jnp.exp(last[..., 0, :])[..., None]
    prev = jnp.moveaxis(carry_linear_state(jnp.moveaxis(decay, 2, 0), jnp.moveaxis(local, 2, 0)), 0, 2)
    o_inter = jnp.einsum('bhntd,bhndv->bhntv', q * jnp.exp(cum), prev)
    o = (o_intra + o_inter).transpose(0, 2, 3, 1, 4).reshape(b, p, HG_WIDTH)[:, LEAD_PAD:]
    return group_rmsnorm(o, norm_w, HG_HEADS) * jax.nn.silu(g)


def mlstm_mixer(q, k, v, o_pre, i_pre, f_pre, b_i, b_f, norm_w):
    b = q.shape[0]
    log_i = softcap(i_pre + b_i)
    log_f = jax.nn.log_sigmoid(softcap(f_pre + b_f))
    q = lead_pad(q * ML_QK ** -0.5)
    k = lead_pad(k)
    v = lead_pad(v)
    log_f = lead_pad(log_f)
    log_i = lead_pad(log_i, NEG)
    p = q.shape[1]
    nc = p // CHUNK

    def chunks(t, dim):
        return t.reshape(b, nc, CHUNK, ML_HEADS, dim).transpose(0, 3, 1, 2, 4)

    def gate_chunks(t):
        return t.reshape(b, nc, CHUNK, ML_HEADS).transpose(0, 3, 1, 2)

    q, k, v = chunks(q, ML_QK), chunks(k, ML_QK), chunks(v, ML_V)
    log_f, log_i = gate_chunks(log_f), gate_chunks(log_i)
    cum = jnp.cumsum(log_f, axis=-1)
    intra = jnp.where(causal_mask(CHUNK),
                      cum[..., :, None] - cum[..., None, :] + log_i[..., None, :], NEG)
    to_end = cum[..., -1:] - cum + log_i
    m_loc = jnp.max(to_end, axis=-1)
    w_end = jnp.exp(to_end - m_loc[..., None])
    c_loc = jnp.einsum('bhns,bhnsd,bhnsv->bhndv', w_end, k, v)
    n_loc = jnp.einsum('bhns,bhnsd->bhnd', w_end, k)
    total = cum[..., -1]

    def step(carry, inp):
        c_st, n_st, m_st = carry
        tot, ml, cl, nl = inp
        m_new = jnp.maximum(tot + m_st, ml)
        a = jnp.exp(tot + m_st - m_new)
        s = jnp.exp(ml - m_new)
        c_new = a[..., None, None] * c_st + s[..., None, None] * cl
        n_new = a[..., None] * n_st + s[..., None] * nl
        return (c_new, n_new, m_new), (c_st, n_st, m_st)

    init = (jnp.zeros((b, ML_HEADS, ML_QK, ML_V), c_loc.dtype),
            jnp.zeros((b, ML_HEADS, ML_QK), c_loc.dtype),
            jnp.zeros((b, ML_HEADS), c_loc.dtype))
    xs = (jnp.moveaxis(total, 2, 0), jnp.moveaxis(m_loc, 2, 0),
          jnp.moveaxis(c_loc, 2, 0), jnp.moveaxis(n_loc, 2, 0))
    _, (c_prev, n_prev, m_prev) = lax.scan(step, init, xs)
    c_prev, n_prev, m_prev = jnp.moveaxis(c_prev, 0, 2), jnp.moveaxis(n_prev, 0, 2), jnp.moveaxis(m_prev, 0, 2)
    inter = cum + m_prev[..., None]
    m_t = jnp.maximum(inter, jnp.max(intra, axis=-1))
    w_inter = jnp.exp(inter - m_t)
    qk = jnp.einsum('bhntd,bhnsd->bhnts', q, k) * jnp.exp(intra - m_t[..., None])
    num = jnp.einsum('bhnts,bhnsv->bhntv', qk, v) + w_inter[..., None] * jnp.einsum('bhntd,bhndv->bhntv', q, c_prev)
    den = jnp.sum(qk, axis=-1) + w_inter * jnp.einsum('bhntd,bhnd->bhnt', q, n_prev)
    h = num / jnp.maximum(jnp.abs(den), jnp.exp(-m_t))[..., None]
    h = h.transpose(0, 2, 3, 1, 4).reshape(b, p, ML_WIDTH)[:, LEAD_PAD:]
    return group_rmsnorm(h, norm_w, ML_HEADS) * jax.nn.sigmoid(o_pre)


def causal_depthwise_conv(x, w):
    return lax.conv_general_dilated(x, w.astype(x.dtype)[:, None, :], window_strides=(1,),
                                    padding=[(CONV_W - 1, 0)],
                                    dimension_numbers=('NWC', 'WIO', 'NWC'),
                                    feature_group_count=x.shape[-1])


def mamba2_mixer(z, xbc, dt_pre, conv_w, conv_b, dt_bias, a_log, d_skip, norm_w):
    b = z.shape[0]
    hpg = SSM_HEADS // SSM_GROUPS
    xbc = jax.nn.silu(causal_depthwise_conv(xbc, conv_w) + conv_b)
    x, bm, cm = split_last(xbc, (SSM_WIDTH, SSM_BC, SSM_BC))
    dt = jax.nn.softplus(dt_pre + dt_bias)
    a = -jnp.exp(a_log)
    x, bm, cm, dt = lead_pad(x), lead_pad(bm), lead_pad(cm), lead_pad(dt)
    p = x.shape[1]
    nc = p // CHUNK
    x = x.reshape(b, nc, CHUNK, SSM_GROUPS, hpg, SSM_HEADDIM)
    dt = dt.reshape(b, nc, CHUNK, SSM_GROUPS, hpg)
    bm = bm.reshape(b, nc, CHUNK, SSM_GROUPS, SSM_STATE)
    cm = cm.reshape(b, nc, CHUNK, SSM_GROUPS, SSM_STATE)
    cum = jnp.cumsum(jnp.moveaxis(dt * a.reshape(SSM_GROUPS, hpg), 2, -1), axis=-1)
    xdt = x * dt[..., None]
    decay_in = jnp.exp(jnp.where(causal_mask(CHUNK), cum[..., :, None] - cum[..., None, :], NEG))
    cb = jnp.einsum('bntgk,bnsgk->bngts', cm, bm)
    y_diag = jnp.einsum('bngts,bnghts,bnsghp->bntghp', cb, decay_in, xdt)
    to_end = jnp.exp(cum[..., -1:] - cum)
    local = jnp.einsum('bnsgk,bnghs,bnsghp->bnghpk', bm, to_end, xdt)
    chunk_decay = jnp.exp(cum[..., -1])[..., None, None]
    prev = jnp.moveaxis(carry_linear_state(jnp.moveaxis(chunk_decay, 1, 0), jnp.moveaxis(local, 1, 0)), 0, 1)
    y_off = jnp.einsum('bntgk,bnght,bnghpk->bntghp', cm, jnp.exp(cum), prev)
    y = y_diag + y_off + x * d_skip.reshape(SSM_GROUPS, hpg)[..., None]
    y = y.reshape(b, p, SSM_WIDTH)[:, LEAD_PAD:]
    return group_rmsnorm(y * jax.nn.silu(z), norm_w, SSM_GROUPS)


def hierarchical_moe(u, w_group, b_group, w_router, b_router, w1, w3, w2):
    b, l, d = u.shape
    t = u.reshape(-1, d)
    n_tok = t.shape[0]
    g_prob = jax.nn.softmax((t @ w_group).astype(jnp.float32) + b_group, axis=-1)
    g_sel = jnp.argmax(g_prob, axis=-1)
    g_gate = jnp.max(g_prob, axis=-1)
    e_logits = jnp.einsum('td,gde->tge', t, w_router).astype(jnp.float32) + b_router
    e_logits = jnp.einsum('tg,tge->te', jax.nn.one_hot(g_sel, N_GROUPS_MOE, dtype=jnp.float32), e_logits)
    top_v, top_i = lax.top_k(e_logits, TOP_K)
    top_w = jax.nn.softmax(top_v, axis=-1) * g_gate[:, None]
    flat_e = (g_sel[:, None] * EXPERTS_PER_GROUP + top_i).reshape(-1).astype(jnp.int32)
    flat_w = top_w.reshape(-1)
    tk = flat_e.shape[0]
    order = jnp.argsort(flat_e).astype(jnp.int32)
    sorted_e = flat_e[order]
    counts = jnp.bincount(flat_e, length=N_EXPERTS).astype(jnp.int32)
    starts = jnp.cumsum(counts) - counts
    padded = (counts + MOE_BLOCK - 1) // MOE_BLOCK * MOE_BLOCK
    pad_ends = jnp.cumsum(padded)
    pad_starts = pad_ends - padded
    dest = pad_starts[sorted_e] + jnp.arange(tk, dtype=jnp.int32) - starts[sorted_e]
    n_blocks = -(-tk // MOE_BLOCK) + N_EXPERTS
    n_rows = n_blocks * MOE_BLOCK
    row_tok = jnp.full((n_rows,), n_tok, jnp.int32).at[dest].set(order // TOP_K)
    row_w = jnp.zeros((n_rows,), flat_w.dtype).at[dest].set(flat_w[order])
    block_e = jnp.minimum(jnp.searchsorted(pad_ends, jnp.arange(n_blocks, dtype=jnp.int32) * MOE_BLOCK,
                                           side='right'), N_EXPERTS - 1)
    t_pad = jnp.concatenate([t, jnp.zeros((1, d), t.dtype)], axis=0)
    xs = t_pad[row_tok].reshape(n_blocks, MOE_BLOCK, d)

    def expert_block(args):
        xb, e = args
        hidden = jax.nn.silu(xb @ w1[e]) * (xb @ w3[e])
        return hidden @ w2[e]

    ys = lax.map(expert_block, (xs, block_e)).reshape(n_rows, d)
    out = jnp.zeros((n_tok + 1, d), ys.dtype).at[row_tok].add(ys * row_w[:, None].astype(ys.dtype))
    return out[:n_tok].reshape(b, l, d)


def setup_inputs(seed: int = 0) -> dict:
    key = jax.random.key(seed)
    ks = jax.random.split(key, 25)

    def nrm(k, shape, scale):
        return jax.random.normal(k, shape, jnp.float32) * scale

    def gain(k, shape):
        return 1.0 + nrm(k, shape, 0.02)

    dt0 = jnp.exp(jax.random.uniform(ks[11], (DEPTH, SSM_HEADS), jnp.float32,
                                     minval=math.log(1e-3), maxval=math.log(1e-1)))
    return {
        'x': nrm(ks[0], (BATCH, SEQ, D_MODEL), 1.0),
        'meta_tokens': nrm(ks[1], (N_META, D_MODEL), 1.0),
        'hg_lb_logits': 1.0 + nrm(ks[2], (DEPTH, HG_KEY), 0.1),
        'norm_mix_w': gain(ks[3], (DEPTH, D_MODEL)),
        'w_in': nrm(ks[4], (DEPTH, D_MODEL, D_IN), D_MODEL ** -0.5),
        'hg_norm_w': gain(ks[5], (DEPTH, HG_WIDTH)),
        'ml_b_i': nrm(ks[6], (DEPTH, ML_HEADS), 0.1),
        'ml_b_f': 3.0 + 3.0 * jax.random.uniform(ks[7], (DEPTH, ML_HEADS), jnp.float32),
        'ml_norm_w': gain(ks[8], (DEPTH, ML_WIDTH)),
        'ssm_conv_w': nrm(ks[9], (DEPTH, CONV_W, CONV_CH), CONV_W ** -0.5),
        'ssm_conv_b': nrm(ks[10], (DEPTH, CONV_CH), 0.01),
        'ssm_dt_bias': dt0 + jnp.log(-jnp.expm1(-dt0)),
        'ssm_a_log': jnp.log(jax.random.uniform(ks[12], (DEPTH, SSM_HEADS), jnp.float32, minval=1.0, maxval=16.0)),
        'ssm_d': 1.0 + nrm(ks[13], (DEPTH, SSM_HEADS), 0.1),
        'ssm_norm_w': gain(ks[14], (DEPTH, SSM_WIDTH)),
        'w_out': nrm(ks[15], (DEPTH, D_MIX, D_MODEL), D_MIX ** -0.5),
        'norm_ffn_w': gain(ks[16], (DEPTH, D_MODEL)),
        'moe_w_group': nrm(ks[17], (DEPTH, D_MODEL, N_GROUPS_MOE), D_MODEL ** -0.5),
        'moe_b_group': nrm(ks[18], (DEPTH, N_GROUPS_MOE), 0.01),
        'moe_w_router': nrm(ks[19], (DEPTH, N_GROUPS_MOE, D_MODEL, EXPERTS_PER_GROUP), D_MODEL ** -0.5),
        'moe_b_router': nrm(ks[20], (DEPTH, N_GROUPS_MOE, EXPERTS_PER_GROUP), 0.01),
        'moe_w1': nrm(ks[21], (DEPTH, N_EXPERTS, D_MODEL, D_EXPERT), D_MODEL ** -0.5),
        'moe_w3': nrm(ks[22], (DEPTH, N_EXPERTS, D_MODEL, D_EXPERT), D_MODEL ** -0.5),
        'moe_w2': nrm(ks[23], (DEPTH, N_EXPERTS, D_EXPERT, D_MODEL), D_EXPERT ** -0.5),
        'final_norm_w': gain(ks[24], (D_MODEL,)),
    }


def reference(x, meta_tokens, hg_lb_logits, norm_mix_w, w_in, hg_norm_w, ml_b_i, ml_b_f, ml_norm_w,
              ssm_conv_w, ssm_conv_b, ssm_dt_bias, ssm_a_log, ssm_d, ssm_norm_w, w_out, norm_ffn_w,
              moe_w_group, moe_b_group, moe_w_router, moe_b_router, moe_w1, moe_w3, moe_w2, final_norm_w):
    b = x.shape[0]
    meta = jnp.broadcast_to(meta_tokens.astype(x.dtype)[None], (b, N_META, D_MODEL))
    h = jnp.concatenate([meta, x], axis=1)
    lb_w = jax.nn.softmax(hg_lb_logits.astype(jnp.float32), axis=0)
    lower_bounds = jnp.cumsum(lb_w, axis=0) - lb_w[0]
    for layer in range(DEPTH):
        u = rmsnorm(h, norm_mix_w[layer])
        proj = (u @ w_in[layer]).astype(jnp.float32)
        (hq, hf, hi, hg, mq, mk, mv, mo, mi, mf, sz, sxbc, sdt) = split_last(proj, IN_SPLITS)
        y_a = hgrn2_mixer(hq, hf, hi, hg, lower_bounds[layer], hg_norm_w[layer])
        y_b = mlstm_mixer(mq, mk, mv, mo, mi, mf, ml_b_i[layer], ml_b_f[layer], ml_norm_w[layer])
        y_c = mamba2_mixer(sz, sxbc, sdt, ssm_conv_w[layer], ssm_conv_b[layer], ssm_dt_bias[layer],
                           ssm_a_log[layer], ssm_d[layer], ssm_norm_w[layer])
        mixed = jnp.concatenate([y_a, y_b, y_c], axis=-1).astype(h.dtype)
        h = h + mixed @ w_out[layer]
        h = h + hierarchical_moe(rmsnorm(h, norm_ffn_w[layer]), moe_w_group[layer], moe_b_group[layer],
                                 moe_w_router[layer], moe_b_router[layer], moe_w1[layer], moe_w3[layer],
                                 moe_w2[layer])
    return rmsnorm(h, final_norm_w)[:, N_META:]
```

```cpp
#define BG_G1 25
#include <hip/hip_runtime.h>
#include <stdint.h>
#include <cstdio>

#define LAS __attribute__((address_space(3)))
#define GAS __attribute__((address_space(1)))
typedef unsigned short bf16_t;
typedef short bf16x8 __attribute__((ext_vector_type(8)));
typedef short bf16x4 __attribute__((ext_vector_type(4)));
typedef float f32x4 __attribute__((ext_vector_type(4)));
typedef float f32x2 __attribute__((ext_vector_type(2)));
typedef unsigned u32x4 __attribute__((ext_vector_type(4)));
typedef unsigned u32x2 __attribute__((ext_vector_type(2)));

constexpr int D = 2048, NB = 4, SEQ = 2048, NMETA = 16, LTOK = SEQ + NMETA, DEPTH = 2;
constexpr int PB = 2112;
constexpr int LEADP = 48;
constexpr int R = NB * PB;
constexpr int NCH = R / 64;
constexpr int CPB = 33;
constexpr int D_IN = 6680, NPROJ = 6656, NGATE = 24;
constexpr int P_HQ = 0, P_HF = 512, P_HI = 1024, P_HG = 1536, P_MQ = 2048, P_MK = 2304, P_MV = 2560, P_MO = 3072, P_SZ = 3584, P_SX = 4608, P_SB = 5632, P_SC = 6144;
constexpr int NE = 32, DE = 512;
constexpr float EPS = 1e-6f;
constexpr int NTHREADS = 512, NWAVES = 8;

typedef __bf16 bf16n2 __attribute__((ext_vector_type(2)));
__device__ __forceinline__ unsigned cvt_pk_bf16(float lo, float hi) { bf16n2 v; v[0] = (__bf16)lo; v[1] = (__bf16)hi; return __builtin_bit_cast(unsigned, v); }
__device__ __forceinline__ bf16_t f2bf(float f) { return (bf16_t)(cvt_pk_bf16(f, 0.f) & 0xffffu); }
__device__ __forceinline__ float bf2f(bf16_t b) { return __uint_as_float(((unsigned)b) << 16); }
__device__ __forceinline__ float bflo(unsigned w) { return __uint_as_float(w << 16); }
__device__ __forceinline__ float bfhi(unsigned w) { return __uint_as_float(w & 0xffff0000u); }
__device__ __forceinline__ void unpack8(const u32x4 w, float (&f)[8]) { f[0] = bflo(w.x); f[1] = bfhi(w.x); f[2] = bflo(w.y); f[3] = bfhi(w.y); f[4] = bflo(w.z); f[5] = bfhi(w.z); f[6] = bflo(w.w); f[7] = bfhi(w.w); }
__device__ __forceinline__ u32x4 pack8(const float (&f)[8]) { u32x4 w; w.x = cvt_pk_bf16(f[0], f[1]); w.y = cvt_pk_bf16(f[2], f[3]); w.z = cvt_pk_bf16(f[4], f[5]); w.w = cvt_pk_bf16(f[6], f[7]); return w; }
__device__ __forceinline__ int opaque_tid() { int t = threadIdx.x; asm volatile("" : "+v"(t)); return t; }
template <int CTRL, int ROWMASK> __device__ __forceinline__ float dpp_add_step(float v) {
    const int t = __builtin_amdgcn_update_dpp(0, __builtin_bit_cast(int, v), CTRL, ROWMASK, 0xF, false);
    return v + __builtin_bit_cast(float, t);
}
__device__ __forceinline__ float sum16_dpp(float v) {
    v = dpp_add_step<0xB1, 0xF>(v); v = dpp_add_step<0x4E, 0xF>(v); v = dpp_add_step<0x141, 0xF>(v); v = dpp_add_step<0x140, 0xF>(v);
    return v;
}
__device__ __forceinline__ float sum32_dpp(float v, int lane) {
    v = sum16_dpp(v);
    v = dpp_add_step<0x142, 0xA>(v);
    const float lo = __builtin_bit_cast(float, __builtin_amdgcn_readlane(__builtin_bit_cast(int, v), 31)), hi = __builtin_bit_cast(float, __builtin_amdgcn_readlane(__builtin_bit_cast(int, v), 63));
    return lane < 32 ? lo : hi;
}
__device__ __forceinline__ float wave_sum(float v) {
    v = dpp_add_step<0xB1, 0xF>(v);
    v = dpp_add_step<0x4E, 0xF>(v);
    v = dpp_add_step<0x141, 0xF>(v);
    v = dpp_add_step<0x140, 0xF>(v);
    v = dpp_add_step<0x142, 0xA>(v);
    v = dpp_add_step<0x143, 0xC>(v);
    return __builtin_bit_cast(float, __builtin_amdgcn_readlane(__builtin_bit_cast(int, v), 63));
}
__device__ __forceinline__ float sigmoidf_(float x) { return __builtin_amdgcn_rcpf(1.f + __expf(-x)); }
__device__ __forceinline__ float siluf_(float x) { return x * __builtin_amdgcn_rcpf(1.f + __expf(-x)); }
__device__ __forceinline__ float softplusf_(float x) { return x > 20.f ? x : log1pf(__expf(x)); }
__device__ __forceinline__ float logsigmoidf_(float x) { return fminf(x, 0.f) - log1pf(__expf(-fabsf(x))); }
#define LDS_WAIT() asm volatile("s_waitcnt lgkmcnt(0)" ::: "memory")
#define VM_WAIT() asm volatile("s_waitcnt vmcnt(0)" ::: "memory")

#define XB_TMO      128
#define XB_XCNT(j)  (256  + 64 * (j))
#define XB_XSUB(j)  (1280 + 64 * (j))
#define XB_XGEN(j)  (2304 + 64 * (j))
#define XB_TOP      3328
#define XB_TOPGEN   3392
#define XCD_BAR_WORDS 3456
#define XB_SPIN_CAP (1u << 18)
__device__ __forceinline__ unsigned xb_ld(unsigned* p)              { return __hip_atomic_load(p, __ATOMIC_RELAXED, __HIP_MEMORY_SCOPE_AGENT); }
__device__ __forceinline__ unsigned xb_add(unsigned* p, unsigned v) { return __hip_atomic_fetch_add(p, v, __ATOMIC_RELAXED, __HIP_MEMORY_SCOPE_AGENT); }
__device__ __forceinline__ unsigned xb_xcc_id() { return (unsigned)__builtin_amdgcn_s_getreg((3 << 11) | 20) & 0xFu; }
#define XB_SPIN(cond, bar) do { unsigned _sp = 0; while (cond) { __builtin_amdgcn_s_sleep(1); \
    if ((++_sp & 255u) == 0u) { if (xb_ld(&(bar)[XB_TMO])) break; if (_sp > XB_SPIN_CAP) { atomicAdd(&(bar)[XB_TMO], 1u); break; } } } } while (0)
struct XcdBarrier { unsigned* bar; unsigned x; volatile LAS unsigned* st; };
__device__ __forceinline__ XcdBarrier xcd_barrier_post(unsigned* bar, volatile LAS unsigned* st) {
    XcdBarrier b; b.bar = bar; b.x = xb_xcc_id(); b.st = st;
    if (threadIdx.x == 0) (void)xb_add(&bar[XB_XCNT(b.x)], 1u);
    return b;
}
__device__ __forceinline__ void xcd_barrier_complete(unsigned* bar, unsigned x, unsigned& nloc, unsigned& nx) {
    const unsigned G = gridDim.x * gridDim.y * gridDim.z;
    unsigned sum, cnt, mine, sp = 0u;
    for (;;) {
        sum = 0u; cnt = 0u; mine = 0u;
#pragma unroll
        for (unsigned j = 0; j < 16; ++j) { const unsigned c = xb_ld(&bar[XB_XCNT(j)]); sum += c; cnt += (c > 0u) ? 1u : 0u; mine = (j == x) ? c : mine; }
        if (sum == G) break;
        __builtin_amdgcn_s_sleep(1);
        if ((++sp & 255u) == 0u) { if (xb_ld(&bar[XB_TMO])) break; if (sp > XB_SPIN_CAP) { atomicAdd(&bar[XB_TMO], 1u); break; } }
    }
    nloc = mine > 0u ? mine : 1u; nx = cnt > 0u ? cnt : 1u;
}
__device__ __forceinline__ void xcd_barrier(const XcdBarrier& b) {
    asm volatile("s_waitcnt vmcnt(0)" ::: "memory");
    __syncthreads();
    if (threadIdx.x == 0) {
        unsigned* bar = b.bar;
        __builtin_amdgcn_s_waitcnt(0);
        unsigned nloc = b.st[0], nx = b.st[1];
        if (nloc == 0u) { xcd_barrier_complete(bar, b.x, nloc, nx); b.st[0] = nloc; b.st[1] = nx; }
        const unsigned old = xb_add(&bar[XB_XSUB(b.x)], 1u);
        const unsigned gen = old / nloc;
        if (old + 1u == (gen + 1u) * nloc) {
            __builtin_amdgcn_fence(__ATOMIC_RELEASE, "agent");
            asm volatile("s_waitcnt vmcnt(0)" ::: "memory");
            const unsigned og = xb_add(&bar[XB_TOP], 1u);
            const unsigned tg = og / nx;
            if (og + 1u == (tg + 1u) * nx) xb_add(&bar[XB_TOPGEN], 1u);
            else XB_SPIN(xb_ld(&bar[XB_TOPGEN]) == tg, bar);
            __builtin_amdgcn_fence(__ATOMIC_ACQUIRE, "agent");
            xb_add(&bar[XB_XGEN(b.x)], 1u);
            asm volatile("s_waitcnt vmcnt(0)" ::: "memory");
        } else {
            XB_SPIN(xb_ld(&bar[XB_XGEN(b.x)]) == gen, bar);
            __builtin_amdgcn_fence(__ATOMIC_ACQUIRE, "agent");
            asm volatile("s_waitcnt vmcnt(0)" ::: "memory");
        }
    }
    __syncthreads();
}
namespace pg8 {
constexpr int BM = 256, BK = 64, HALF = 128, HTB = HALF * BK * 2, STAGE_BYTES = 8 * HTB, NXCD = 8, WGM = 8;
__host__ __device__ __forceinline__ int lds_byte(int r, int c) { const int st = (r >> 4) * 2 + (c >> 5), rr = r & 15, cc = c & 31, ob = rr * 64 + cc * 2; return st * 1024 + (ob ^ (((ob >> 9) & 1) << 5)); }
__host__ __device__ __forceinline__ void stage_rc(int b, int& Rr, int& C) { const int st = b / 1024, sb = b % 1024, swz = sb ^ (((sb >> 9) & 1) << 5); Rr = (st >> 1) * 16 + swz / 64; C = (st & 1) * 32 + (swz % 64) / 2; }
__host__ __device__ __forceinline__ int perm32(int rho) { const int n = rho >> 4, i = rho & 15; return 8 * (i >> 2) + 4 * n + (i & 3); }

struct GU { const char* a; const char* b0; const char* b1; int r0; int c0; int ex; int half; };

struct TileOrder {
    int nM, nN, nwg, G, c;
    __device__ void init(int nM_, int nN_, int G_, int c_) { nM = nM_; nN = nN_; nwg = nM * nN; G = G_; c = c_; }
    __device__ bool tile(int i, int& pm, int& pn) const {
        const long Lx = (long)i * G + c; if (Lx >= nwg) return false;
        int wgid = (int)Lx; { const int q = nwg / NXCD, r = nwg % NXCD, xcd = wgid % NXCD, off = wgid / NXCD; wgid = (xcd < r ? xcd * (q + 1) : r * (q + 1) + (xcd - r) * q) + off; }
        const int nig = WGM * nN, gid = wgid / nig, fm = gid * WGM, gsz = (nM - fm) < WGM ? (nM - fm) : WGM;
        pm = fm + ((wgid % nig) % gsz); pn = (wgid % nig) / gsz; return true;
    }
};

template <class Epi, class Sched, bool GATHER, int BMODE = 0>
__device__ __forceinline__ void gemm_phase(LAS unsigned char* lds, const int K, const Sched& S, const Epi& E) {
    const int tid = opaque_tid(), wid = __builtin_amdgcn_readfirstlane(tid >> 6), lane = tid & 63, wr = wid >> 2, wc = wid & 3, fr = lane & 15, fq = lane >> 4;
    const int nt = K / BK;
    unsigned voffB[2], vAc[2][2], vAn[2][2];
#pragma unroll
    for (int i = 0; i < 2; ++i) { int Rr_, Cc_; stage_rc(tid * 16 + i * 8192, Rr_, Cc_); const int Rb = Epi::PERM ? ((Rr_ & ~31) + perm32(Rr_ & 31)) : Rr_;
        if constexpr (BMODE == 0) voffB[i] = (unsigned)(Rb * K + Cc_) * 2u;
        else { static_assert(BMODE == 0 || !Epi::PERM, "BMODE 1 needs PERM == false"); const int c = wid * 64 + i * 512 + lane, k = c >> 4, slot = c & 15, ch = slot ^ (((k & 3) << 2) | ((k >> 2) & 3));
            voffB[i] = (unsigned)k * (unsigned)S.ldb + (unsigned)ch * 16u; } }
    const size_t kstep = (size_t)(BK * 2);
    size_t kstepB = kstep; if constexpr (BMODE == 1) kstepB = (size_t)BK * (size_t)S.ldb;
    unsigned tb[2][2];
    if constexpr (BMODE == 1) { const int q = fr >> 2, pq = fr & 3;
#pragma unroll
        for (int n = 0; n < 2; ++n)
#pragma unroll
            for (int t = 0; t < 2; ++t) { const int row = 8 * fq + 4 * t + q, chunk = wc * 4 + 2 * n + (pq >> 1), swz = (q << 2) | ((2 * fq + t) & 3);
                tb[n][t] = (unsigned)(size_t)lds + (unsigned)(4 * HTB + 256 * row + 16 * (chunk ^ swz) + 8 * (pq & 1)); } }
    const unsigned ldsw = (unsigned)wid * 1024u;
    const int aoff = lds_byte(wr * 64 + fr, fq * 8), boff = lds_byte(wc * 32 + fr, fq * 8);
#define PG8_SA(b, h) (((b) * 2 + (h)) * HTB)
#define PG8_SB(b, h) ((4 + (b) * 2 + (h)) * HTB)
#define PG8_STAGE(bufoff, gbase, voff) do { _Pragma("unroll") for (int _i = 0; _i < 2; ++_i) \
        __builtin_amdgcn_global_load_lds((const unsigned*)((const char*)(gbase) + (voff)[_i]), (LAS unsigned*)(lds + (bufoff) + ldsw + _i * 8192), 16, 0, 0); } while (0)
#define PG8_LDA(dst, b, h) do { _Pragma("unroll") for (int m = 0; m < 4; ++m) _Pragma("unroll") for (int k = 0; k < 2; ++k) dst[m][k] = *(const LAS bf16x8*)(lds + PG8_SA(b, h) + aoff + m * 2048 + k * 1024); } while (0)
#define PG8_TR1(dstv, n, k, b, h) do { bf16x4 _lo, _hi; \
            asm volatile("ds_read_b64_tr_b16 %0, %1 offset:%2" : "=v"(_lo) : "v"(tb[n][0]), "i"((((b) * 2 + (h)) * 16384 + (k) * 8192)) : "memory"); \
            asm volatile("ds_read_b64_tr_b16 %0, %1 offset:%2" : "=v"(_hi) : "v"(tb[n][1]), "i"((((b) * 2 + (h)) * 16384 + (k) * 8192)) : "memory"); \
            dstv = __builtin_shufflevector(_lo, _hi, 0, 1, 2, 3, 4, 5, 6, 7); } while (0)
#define PG8_LDB(dst, b, h) do { if constexpr (BMODE == 0) { _Pragma("unroll") for (int n = 0; n < 2; ++n) _Pragma("unroll") for (int k = 0; k < 2; ++k) dst[n][k] = *(const LAS bf16x8*)(lds + PG8_SB(b, h) + boff + n * 2048 + k * 1024); } \
        else { PG8_TR1(dst[0][0], 0, 0, b, h); PG8_TR1(dst[0][1], 0, 1, b, h); PG8_TR1(dst[1][0], 1, 0, b, h); PG8_TR1(dst[1][1], 1, 1, b, h); } } while (0)
#define PG8_MMA(ai, bj, At, Bt) do { __builtin_amdgcn_s_setprio(1); _Pragma("unroll") for (int m = 0; m < 4; ++m) _Pragma("unroll") for (int n = 0; n < 2; ++n) _Pragma("unroll") for (int k = 0; k < 2; ++k) \
        acc[ai][bj][m][n] = __builtin_amdgcn_mfma_f32_16x16x32_bf16(Bt[n][k], At[m][k], acc[ai][bj][m][n], 0, 0, 0); __builtin_amdgcn_s_setprio(0); } while (0)
#define PG8_STAGE_A2(bufoff, gbase, h) do { if (GATHER && last) PG8_STAGE(bufoff, gbase, vAn[h]); else PG8_STAGE(bufoff, gbase, vAc[h]); } while (0)
#define PG8_WAIT_V(n) asm volatile("s_waitcnt vmcnt(" #n ")" ::: "memory")
#define PG8_WAIT_L(n) asm volatile("s_waitcnt lgkmcnt(" #n ")" ::: "memory")
#define PG8_BAR __builtin_amdgcn_s_barrier()
#define PG8_SCHED __builtin_amdgcn_sched_barrier(0)
#define PG8_AOFF(u, v) do { const int _t = opaque_tid(); _Pragma("unroll") for (int _i = 0; _i < 2; ++_i) { int _R, _C; stage_rc(_t * 16 + _i * 8192, _R, _C); _Pragma("unroll") for (int _h = 0; _h < 2; ++_h) \
        (v)[_h][_i] = GATHER ? ((unsigned)S.row((u), _h * 128 + _R) * (unsigned)K + (unsigned)_C) * 2u : ((unsigned)(_h * 128 + _R) * (unsigned)K + (unsigned)_C) * 2u; } } while (0)
    GU cur, nxt; int ui = 0;
    if (!S.next(0, cur)) return;
    f32x4 acc[2][2][4][2];
#pragma unroll
    for (int a = 0; a < 2; ++a)
#pragma unroll
        for (int b = 0; b < 2; ++b)
#pragma unroll
            for (int m = 0; m < 4; ++m)
#pragma unroll
                for (int n = 0; n < 2; ++n) acc[a][b][m][n] = (f32x4){0.f, 0.f, 0.f, 0.f};
    bf16x8 At[4][2], B0[2][2], B1[2][2];
    PG8_AOFF(cur, vAc);
    if (GATHER) { VM_WAIT(); }
    const char* cA = cur.a; const char* cB0 = cur.b0; const char* cB1 = cur.b1;
    PG8_STAGE(PG8_SB(0, 0), cB0, voffB); PG8_STAGE(PG8_SB(0, 1), cB1, voffB); PG8_STAGE(PG8_SA(0, 0), cA, vAc[0]); PG8_STAGE(PG8_SA(0, 1), cA, vAc[1]);
    if (wr == 1) PG8_BAR;
    PG8_WAIT_V(2); PG8_BAR;
    PG8_STAGE(PG8_SB(1, 0), cB0 + kstepB, voffB); PG8_STAGE(PG8_SA(1, 0), cA + kstep, vAc[0]); PG8_STAGE(PG8_SB(1, 1), cB1 + kstepB, voffB);
    PG8_WAIT_V(6); PG8_BAR;
    for (;;) {
        const bool has_next = S.next(ui + 1, nxt);
        const char* nA = has_next ? nxt.a : cA; const char* nB0 = has_next ? nxt.b0 : cB0; const char* nB1 = has_next ? nxt.b1 : cB1;
        for (int t = 0; t < nt; t += 2) {
            const bool last = (t == nt - 2);
            const char* a1 = cA + (size_t)(t + 1) * kstep;
            const char* a2 = last ? nA : cA + (size_t)(t + 2) * kstep;
            const char* b20 = last ? nB0 : cB0 + (size_t)(t + 2) * kstepB; const char* b21 = last ? nB1 : cB1 + (size_t)(t + 2) * kstepB;
            const char* a3 = a2 + kstep; const char* b30 = b20 + kstepB; const char* b31 = b21 + kstepB;
            if (GATHER && last) { if (has_next) { PG8_AOFF(nxt, vAn); } else {
#pragma unroll
                for (int h = 0; h < 2; ++h)
#pragma unroll
                    for (int i = 0; i < 2; ++i) vAn[h][i] = vAc[h][i]; } }
            PG8_LDB(B0, 0, 0); PG8_LDB(B1, 0, 1); PG8_SCHED; PG8_LDA(At, 0, 0); PG8_STAGE(PG8_SA(1, 1), a1, vAc[1]);
            PG8_WAIT_V(8); PG8_WAIT_L(0); PG8_BAR; PG8_MMA(0, 0, At, B0); PG8_MMA(0, 1, At, B1); PG8_BAR; PG8_SCHED;
            PG8_LDA(At, 0, 1); PG8_STAGE(PG8_SB(0, 0), b20, voffB); PG8_STAGE(PG8_SB(0, 1), b21, voffB); PG8_STAGE_A2(PG8_SA(0, 0), a2, 0);
            PG8_WAIT_V(8); PG8_WAIT_L(0); PG8_BAR; if (!cur.half) { PG8_MMA(1, 0, At, B0); PG8_MMA(1, 1, At, B1); } PG8_BAR; PG8_SCHED;
            PG8_LDB(B0, 1, 0); PG8_LDB(B1, 1, 1); PG8_SCHED; PG8_LDA(At, 1, 0); PG8_STAGE_A2(PG8_SA(0, 1), a2, 1);
            PG8_WAIT_V(8); PG8_WAIT_L(0); PG8_BAR; PG8_MMA(0, 0, At, B0); PG8_MMA(0, 1, At, B1); PG8_BAR; PG8_SCHED;
            PG8_LDA(At, 1, 1); PG8_STAGE(PG8_SB(1, 0), b30, voffB); PG8_STAGE(PG8_SB(1, 1), b31, voffB); PG8_STAGE_A2(PG8_SA(1, 0), a3, 0);
            PG8_WAIT_V(8); PG8_WAIT_L(0); PG8_BAR; if (!cur.half) { PG8_MMA(1, 0, At, B0); PG8_MMA(1, 1, At, B1); } PG8_BAR; PG8_SCHED;
        }
        if (wr == 0) PG8_BAR;
        E(acc, cur, wr, wc, fr, fq);
        if (!has_next) break;
#pragma unroll
        for (int a = 0; a < 2; ++a)
#pragma unroll
            for (int b = 0; b < 2; ++b)
#pragma unroll
                for (int m = 0; m < 4; ++m)
#pragma unroll
                    for (int n = 0; n < 2; ++n) acc[a][b][m][n] = (f32x4){0.f, 0.f, 0.f, 0.f};
        cur = nxt; cA = nA; cB0 = nB0; cB1 = nB1; ++ui;
        if (GATHER) {
#pragma unroll
            for (int h = 0; h < 2; ++h)
#pragma unroll
                for (int i = 0; i < 2; ++i) vAc[h][i] = vAn[h][i]; }
        if (wr == 1) PG8_BAR;
    }
    PG8_WAIT_V(0);
    PG8_BAR;
#undef PG8_SA
#undef PG8_SB
#undef PG8_STAGE
#undef PG8_LDA
#undef PG8_LDB
#undef PG8_TR1
#undef PG8_MMA
#undef PG8_WAIT_V
#undef PG8_WAIT_L
#undef PG8_BAR
#undef PG8_SCHED
#undef PG8_AOFF
#undef PG8_STAGE_A2
}
}
struct Params {
    const float* x; const float* meta; const float* lbl; const float* nmw; const float* w_in; const float* hgnw; const float* mbi; const float* mbf; const float* mlnw;
    const float* cw; const float* cb; const float* dtb; const float* alog; const float* dsk; const float* ssnw; const float* w_out; const float* nfw; const float* wg; const float* bg;
    const float* wr; const float* br; const float* w1; const float* w3; const float* w2; const float* fnw;
    float* out; unsigned char* ws;
};
constexpr size_t MiB = 1u << 20;
constexpr size_t al256(size_t x) { return (x + 255) / 256 * 256; }
constexpr size_t WS_CTL = 0, CTL_BYTES = 65536;
constexpr int CW_BAR = 0;
constexpr int CW_CNT = 4096;
constexpr size_t WS_WTIN  = WS_CTL + CTL_BYTES;
constexpr int NPROJX = NPROJ + 256;
constexpr size_t WS_WGIN  = WS_WTIN + al256((size_t)DEPTH * D * D_IN * 2);
constexpr size_t WS_WTOUT = WS_WGIN + al256((size_t)DEPTH * NGATE * D * 4);
constexpr size_t WS_WRT   = WS_WTOUT + al256((size_t)DEPTH * D * D * 2);
constexpr size_t WRF_LAYER = (size_t)64 * 3 * 2 * 64 * 8;
constexpr size_t WS_H0    = WS_WRT + al256((size_t)DEPTH * WRF_LAYER * 2);
constexpr size_t WS_H1    = WS_H0 + al256((size_t)R * D * 4);
constexpr size_t WS_U     = WS_H1 + al256((size_t)R * D * 4);
constexpr size_t WS_PROJ  = WS_U + al256((size_t)R * D * 2);
constexpr size_t WS_GATES = WS_PROJ + al256((size_t)R * NPROJ * 2);
constexpr size_t WS_MIXED = WS_GATES + al256((size_t)R * NGATE * 4);
constexpr size_t WS_COMMON_END = WS_MIXED + al256((size_t)R * D * 2);
constexpr int LDS_BYTES = 147456;
constexpr int LDS_BARW = LDS_BYTES - 64;
constexpr int LDS_PARAMS = LDS_BYTES - 64 - 256;
constexpr int LDS_QSLOT = LDS_PARAMS + 8 * 28;
__device__ __forceinline__ const void* lds_ptr(LAS unsigned char* lds, int i) {
    const u32x2 w = *(const LAS u32x2*)(lds + LDS_PARAMS + 8 * i);
    const unsigned lo = __builtin_amdgcn_readfirstlane(w.x), hi = __builtin_amdgcn_readfirstlane(w.y);
    GAS const void* g = (GAS const void*)(((unsigned long long)hi << 32) | lo);
    return (const void*)g;
}
__device__ __forceinline__ void p0_stream_convert(const float* src, bf16_t* dst, size_t n8, size_t gt, size_t NGT) {
#pragma unroll 4
    for (size_t i = gt; i < n8; i += NGT) {
        const f32x4 a = __builtin_nontemporal_load((const f32x4*)(src + i * 8)), b = __builtin_nontemporal_load((const f32x4*)(src + i * 8 + 4));
        u32x4 o; o.x = cvt_pk_bf16(a.x, a.y); o.y = cvt_pk_bf16(a.z, a.w); o.z = cvt_pk_bf16(b.x, b.y); o.w = cvt_pk_bf16(b.z, b.w);
        *(u32x4*)(dst + i * 8) = o;
    }
}
__device__ __forceinline__ void phase_p0(const Params& p, LAS unsigned char* lds) {
    (void)lds;
    const int tid = opaque_tid();
    const size_t gt = (size_t)blockIdx.x * NTHREADS + tid, NGT = (size_t)gridDim.x * NTHREADS;
    p0_stream_convert(p.w_in, (bf16_t*)(p.ws + WS_WTIN), (size_t)DEPTH * D * D_IN / 8, gt, NGT);
    p0_stream_convert(p.w_out, (bf16_t*)(p.ws + WS_WTOUT), (size_t)DEPTH * D * D / 8, gt, NGT);
    bf16_t* wrf = (bf16_t*)(p.ws + WS_WRT);
    for (int i = (int)gt; i < DEPTH * 64 * 3 * 64; i += (int)NGT) {
        const int l = i / (64 * 3 * 64), ks = (i / (3 * 64)) % 64, ct = (i / 64) % 3, ln = i % 64;
        const int col = ct * 16 + (ln & 15);
        float hi[8], lo[8];
#pragma unroll
        for (int j = 0; j < 8; ++j) { const int k = ks * 32 + (ln >> 4) * 8 + j;
            float v = 0.f;
            if (col < 4) v = p.wg[((size_t)l * D + k) * 4 + col];
            else if (col < 36) { const int e = col - 4, g = e >> 3, ee = e & 7; v = p.wr[(((size_t)l * 4 + g) * D + k) * 8 + ee]; }
            v *= p.nfw[(size_t)l * D + k];
            hi[j] = bf2f(f2bf(v)); lo[j] = v - hi[j]; }
        bf16_t* dst = wrf + (size_t)l * WRF_LAYER + ((((size_t)ks * 3 + ct) * 2) * 64 + ln) * 8;
        *(u32x4*)dst = pack8(hi); *(u32x4*)(dst + 64 * 8) = pack8(lo);
    }
}

struct N1Src { const float* hsrc; int layer_prev; int pad; };
template <int MODE>
__device__ __forceinline__ void n1_load_row(const Params& p, const N1Src& s, int excl, int r, int lane, f32x4 (&v)[8]);
__device__ __forceinline__ int combine_excl(const Params& p, int layer, int lane);

#ifndef N1_NT
#define N1_NT 0
#endif
#if N1_NT
#define N1_ST(v, p) __builtin_nontemporal_store((v), (p))
#define N1_LD(p) __builtin_nontemporal_load(p)
#else
#define N1_ST(v, p) (*(p) = (v))
#define N1_LD(p) (*(p))
#endif
template <int MODE>
__device__ __forceinline__ void phase_n1(const Params& p, int layer, const N1Src& src) {
    const int tid = opaque_tid(), lane = tid & 63, wave = __builtin_amdgcn_readfirstlane(tid >> 6);
    const int gw = blockIdx.x * NWAVES + wave, NGW = gridDim.x * NWAVES;
    float* h0 = (float*)(p.ws + WS_H0); bf16_t* U = (bf16_t*)(p.ws + WS_U);
    const float* wn = p.nmw + (size_t)layer * D;
    f32x4 wv[8];
#pragma unroll
    for (int j = 0; j < 8; ++j) wv[j] = *(const f32x4*)(wn + 4 * lane + 256 * j);
    const int excl = (MODE == 2) ? combine_excl(p, src.layer_prev, lane) : 0;
    for (int task = gw; task < R / 2; task += NGW) {
        f32x4 v[2][8];
#pragma unroll
        for (int q = 0; q < 2; ++q) n1_load_row<MODE>(p, src, excl, 2 * task + q, lane, v[q]);
#pragma unroll
        for (int q = 0; q < 2; ++q) {
            const int r = 2 * task + q;
            float ss = 0.f;
#pragma unroll
            for (int j = 0; j < 8; ++j) { if (MODE != 0) N1_ST(v[q][j], (f32x4*)(h0 + (size_t)r * D + 4 * lane + 256 * j)); ss += (v[q][j].x * v[q][j].x + v[q][j].y * v[q][j].y) + (v[q][j].z * v[q][j].z + v[q][j].w * v[q][j].w); }
            const float rs = rsqrtf(wave_sum(ss) * (1.f / D) + EPS);
#pragma unroll
            for (int j = 0; j < 8; ++j) { v[q][j] = v[q][j] * rs * wv[j];
                u32x2 o; o.x = cvt_pk_bf16(v[q][j].x, v[q][j].y); o.y = cvt_pk_bf16(v[q][j].z, v[q][j].w);
                *(u32x2*)(U + (size_t)r * D + 4 * lane + 256 * j) = o; }
        }
    }
}
template <>
__device__ __forceinline__ void n1_load_row<0>(const Params& p, const N1Src&, int, int r, int lane, f32x4 (&v)[8]) {
    const int b = r / PB, pp = r % PB;
    if (pp < LEADP) {
#pragma unroll
        for (int j = 0; j < 8; ++j) v[j] = (f32x4){0.f, 0.f, 0.f, 0.f};
    } else {
        const int l = pp - LEADP;
        const float* s = l < NMETA ? p.meta + (size_t)l * D : p.x + ((size_t)b * SEQ + (l - NMETA)) * D;
#pragma unroll
        for (int j = 0; j < 8; ++j) v[j] = *(const f32x4*)(s + 4 * lane + 256 * j);
    }
}
template <>
__device__ __forceinline__ void n1_load_row<1>(const Params& p, const N1Src& sr, int, int r, int lane, f32x4 (&v)[8]) {
    const int b = r / PB, pp = r % PB;
    if (pp < LEADP) {
#pragma unroll
        for (int j = 0; j < 8; ++j) v[j] = (f32x4){0.f, 0.f, 0.f, 0.f};
    } else {
        const float* s = sr.hsrc + ((size_t)b * LTOK + (pp - LEADP)) * D;
#pragma unroll
        for (int j = 0; j < 8; ++j) v[j] = *(const f32x4*)(s + 4 * lane + 256 * j);
    }
}

struct SchedPlain {
    static constexpr int ldb = 0;
    pg8::TileOrder T; const char* A; const char* Bt; int K;
    __device__ bool next(int i, pg8::GU& u) const { int pm, pn; if (!T.tile(i, pm, pn)) return false;
        u.a = A + (size_t)pm * 256 * K * 2; u.b0 = Bt + (size_t)pn * 256 * K * 2; u.b1 = u.b0 + (size_t)128 * K * 2; u.r0 = pm * 256; u.c0 = pn * 256; u.ex = 0; u.half = 0; return true; }
    __device__ int row(const pg8::GU&, int) const { return 0; }
};
struct EpiBf16Store {
    static constexpr bool PERM = true;
    bf16_t* O; int ldc;
    __device__ __forceinline__ void operator()(const f32x4 (&acc)[2][2][4][2], const pg8::GU& u, int wr, int wc, int fr, int fq) const {
        const int row0 = u.r0 + wr * 64 + fr, col0 = u.c0 + wc * 32 + 8 * fq;
#pragma unroll
        for (int ai = 0; ai < 2; ++ai)
#pragma unroll
            for (int m = 0; m < 4; ++m) { bf16_t* rowp = O + (size_t)(row0 + ai * 128 + m * 16) * ldc + col0;
#pragma unroll
                for (int bj = 0; bj < 2; ++bj) { const f32x4 v0 = acc[ai][bj][m][0], v1 = acc[ai][bj][m][1];
                    u32x4 w; w.x = cvt_pk_bf16(v0[0], v0[1]); w.y = cvt_pk_bf16(v0[2], v0[3]); w.z = cvt_pk_bf16(v1[0], v1[1]); w.w = cvt_pk_bf16(v1[2], v1[3]);
                    *(u32x4*)(rowp + bj * 128) = w; } }
    }
};
#ifndef NT_EPI
#define NT_EPI 0
#endif
#if NT_EPI
#define NT_STORE(v, p) __builtin_nontemporal_store((v), (p))
#else
#define NT_STORE(v, p) (*(p) = (v))
#endif
struct SchedG1 {
    static constexpr int ldb = D_IN * 2;
    pg8::TileOrder T; const char* A; const char* W;
    __device__ bool next(int i, pg8::GU& u) const { int pm, pn; if (!T.tile(i, pm, pn)) return false;
        u.a = A + (size_t)pm * 256 * D * 2; u.r0 = pm * 256; u.c0 = pn * 256; u.ex = 0; u.half = 0;
        if (pn < NPROJ / 256) { const int sc = u.c0 < 3584 ? u.c0 : u.c0 + 8; u.b0 = W + (size_t)sc * 2; u.b1 = u.b0 + 256; }
        else { u.b0 = W + (size_t)3584 * 2; u.b1 = W + (size_t)6664 * 2; }
        return true; }
    __device__ int row(const pg8::GU&, int) const { return 0; }
};
struct EpiProj {
    static constexpr bool PERM = false;
    bf16_t* O; float* G;
    __device__ __forceinline__ void operator()(const f32x4 (&acc)[2][2][4][2], const pg8::GU& u, int wr, int wc, int fr, int fq) const {
        const int row0 = u.r0 + wr * 64 + fr;
        if (u.c0 < NPROJ) {
            const int col0 = u.c0 + wc * 32 + 4 * fq;
#pragma unroll
            for (int ai = 0; ai < 2; ++ai) if (ai == 0 || !u.half)
#pragma unroll
                for (int m = 0; m < 4; ++m) { bf16_t* rowp = O + (size_t)(row0 + ai * 128 + m * 16) * NPROJ + col0;
#pragma unroll
                    for (int bj = 0; bj < 2; ++bj)
#pragma unroll
                        for (int n = 0; n < 2; ++n) { const f32x4 v = acc[ai][bj][m][n]; u32x2 o; o.x = cvt_pk_bf16(v[0], v[1]); o.y = cvt_pk_bf16(v[2], v[3]); NT_STORE(o, (u32x2*)(rowp + bj * 128 + n * 16)); } }
        } else if (wc == 0) {
#pragma unroll
            for (int ai = 0; ai < 2; ++ai) if (ai == 0 || !u.half)
#pragma unroll
                for (int m = 0; m < 4; ++m) { float* gp = G + (size_t)(row0 + ai * 128 + m * 16) * NGATE;
                    if (fq < 2) *(f32x4*)(gp + 4 * fq) = acc[ai][0][m][0];
                    *(f32x4*)(gp + 8 + 4 * fq) = acc[ai][1][m][0]; }
        }
    }
};
__device__ __forceinline__ void phase_g1(const Params& p, int layer, LAS unsigned char* lds) {
    SchedG1 S; S.T.init(R / 256, NPROJX / 256, gridDim.x, blockIdx.x); S.A = (const char*)(p.ws + WS_U); S.W = (const char*)(p.ws + WS_WTIN) + (size_t)layer * D * D_IN * 2;
    EpiProj E{(bf16_t*)(p.ws + WS_PROJ), (float*)(p.ws + WS_GATES)};
    pg8::gemm_phase<EpiProj, SchedG1, false, 1>(lds, D, S, E);
}
constexpr size_t WS_ST_S  = WS_COMMON_END;
constexpr size_t WS_ST_M  = WS_ST_S + al256((size_t)NCH * 16 * 8192 * 2);
constexpr size_t WS_ST_H  = WS_ST_M + al256((size_t)NCH * 4 * 8192 * 2);
constexpr size_t WS_DEC_S = WS_ST_H + al256((size_t)NCH * 4 * 16384 * 2);
constexpr size_t WS_NV_M  = WS_DEC_S + al256((size_t)NCH * 16 * 4);
constexpr size_t WS_SC_M  = WS_NV_M + al256((size_t)NCH * 4 * 64 * 4);
constexpr size_t WS_DEC_H = WS_SC_M + al256((size_t)NCH * 4 * 2 * 4);
constexpr size_t WS_MP_M  = WS_DEC_H + al256((size_t)NCH * 4 * 128 * 4);
constexpr size_t WS_MIX_END = WS_MP_M + al256((size_t)NCH * 4 * 4);

__device__ __forceinline__ f32x4 mfma16(bf16x8 a, bf16x8 b, f32x4 c) { return __builtin_amdgcn_mfma_f32_16x16x32_bf16(a, b, c, 0, 0, 0); }
template <int P> __device__ __forceinline__ bf16x8 frag_row(LAS const unsigned char* base, int row0, int k0, int fr, int fq) {
    return *(const LAS bf16x8*)(base + (row0 + fr) * P + (k0 + 8 * fq) * 2);
}
template <int P> __device__ __forceinline__ bf16x8 frag_tr(LAS const unsigned char* base, int k0, int col0, int lane) {
    const int g = lane >> 4, q = (lane & 15) >> 2, pp = lane & 3;
    const unsigned a = (unsigned)(size_t)base + (unsigned)((k0 + 8 * g + q) * P + (col0 + 4 * pp) * 2);
    bf16x4 lo, hi;
    asm volatile("ds_read_b64_tr_b16 %0, %2\n\tds_read_b64_tr_b16 %1, %2 offset:%3\n\ts_waitcnt lgkmcnt(0)" : "=&v"(lo), "=&v"(hi) : "v"(a), "i"(4 * P) : "memory");
    bf16x8 r; r[0] = lo[0]; r[1] = lo[1]; r[2] = lo[2]; r[3] = lo[3]; r[4] = hi[0]; r[5] = hi[1]; r[6] = hi[2]; r[7] = hi[3];
    return r;
}
__device__ __forceinline__ float wave_scan_incl(float v, int lane) {
#pragma unroll
    for (int o = 1; o < 64; o <<= 1) { const float t = __shfl_up(v, o); if (lane >= o) v += t; }
    return v;
}
__device__ __forceinline__ float wave_scan_max_incl(float v, int lane) {
#pragma unroll
    for (int o = 1; o < 64; o <<= 1) { const float t = __shfl_up(v, o); if (lane >= o) v = fmaxf(v, t); }
    return v;
}
__device__ __forceinline__ float wave_max(float v) {
#pragma unroll
    for (int o = 1; o < 64; o <<= 1) v = fmaxf(v, __shfl_xor(v, o));
    return v;
}
template <int KS> __device__ __forceinline__ int frag_off4(int n, int kbase) {
    return (((n >> 4) * KS + (kbase >> 5)) * 64 + ((kbase & 31) >> 3) * 16 + (n & 15)) * 8 + (kbase & 7);
}

#ifndef SCAN_NT
#define SCAN_NT 0
#endif
#if SCAN_NT
#define SCAN_LD(p) __builtin_nontemporal_load(p)
#else
#define SCAN_LD(p) (*(p))
#endif
#ifndef PROBE_D
#define PROBE_D d
#endif
#ifndef PROBE_L
#define PROBE_L 1.f
#endif
#ifndef SSD_RPT_CONV
#define SSD_RPT_CONV 1
#endif
#ifndef SSD_RPT_S3
#define SSD_RPT_S3 1
#endif
#ifndef SSD_RPT_S4
#define SSD_RPT_S4 1
#endif
#ifndef SSD_RPT_EPI
#define SSD_RPT_EPI 1
#endif
#ifndef SSD_RPT_GATES
#define SSD_RPT_GATES 1
#endif
namespace ssd {
constexpr int PC = 272, PX = 528, PM = 144;
constexpr int OFF_C = 0, OFF_B = 64 * PC, OFF_X = OFF_B + 64 * PC, OFF_M = OFF_X + 64 * PX, OFF_CUM = OFF_M + 4 * 64 * PM, OFF_END = OFF_CUM + 3 * 4 * 64 * 4;
constexpr int PY = 260;
static_assert(OFF_B + 64 * PY * 4 <= OFF_CUM, "Y staging overlays B, X, M");

__device__ __forceinline__ void gates(const Params& p, int layer, LAS unsigned char* lds, int c, int g, bool phaseA) {
    const int tid = opaque_tid(), lane = tid & 63, wave = __builtin_amdgcn_readfirstlane(tid >> 6);
    LAS float* cum = (LAS float*)(lds + OFF_CUM); LAS float* dtv = cum + 256; LAS float* wend = cum + 512;
    if (wave < 4) {
        const int hd = 4 * g + wave, row = c * 64 + lane, pp = row % PB;
        const float* gates = (const float*)(p.ws + WS_GATES);
        float dt = 0.f;
        if (pp >= LEADP) dt = softplusf_(gates[(size_t)row * NGATE + 8 + hd] + p.dtb[layer * 16 + hd]);
        const float a = -__expf(p.alog[layer * 16 + hd]);
        const float cs = wave_scan_incl(dt * a, lane);
        const float last = __shfl(cs, 63);
        cum[wave * 64 + lane] = cs; dtv[wave * 64 + lane] = dt; wend[wave * 64 + lane] = __expf(last - cs);
        if (phaseA && lane == 0) ((float*)(p.ws + WS_DEC_S))[c * 16 + hd] = __expf(last);
    }
}
struct ConvRegs { u32x4 raw[11]; f32x4 w[4][2]; f32x4 b[2]; };
__device__ __forceinline__ void conv_load(const Params& p, int layer, int c, int g, int ncg, ConvRegs& Rg) {
    const int tid = opaque_tid(), cg = tid & 63, rb = tid >> 6;
    const int cgc = cg < ncg ? cg : 0;
    const int n = c % CPB;
    const int ci = cgc < 32 ? g * 256 + cgc * 8 : (cgc < 48 ? 1024 + g * 128 + (cgc - 32) * 8 : 1536 + g * 128 + (cgc - 48) * 8);
    const float* cw = p.cw + (size_t)layer * 4 * 2048 + ci; const float* cb = p.cb + (size_t)layer * 2048 + ci;
#pragma unroll
    for (int t = 0; t < 4; ++t) { Rg.w[t][0] = *(const f32x4*)(cw + t * 2048); Rg.w[t][1] = *(const f32x4*)(cw + t * 2048 + 4); }
    Rg.b[0] = *(const f32x4*)cb; Rg.b[1] = *(const f32x4*)(cb + 4);
    const bf16_t* src = (const bf16_t*)(p.ws + WS_PROJ) + (size_t)(c * 64) * NPROJ + P_SX + ci;
#pragma unroll
    for (int i = 0; i < 11; ++i) { const int s = rb * 8 - 3 + i;
        if (s < 0 && n == 0) Rg.raw[i] = (u32x4){0u, 0u, 0u, 0u}; else Rg.raw[i] = *(const u32x4*)(src + (ptrdiff_t)s * NPROJ); }
}
__device__ __forceinline__ void conv_compute(LAS unsigned char* lds, int ncg, LAS const float* xs0, LAS const float* xs1, const ConvRegs& Rg, bf16_t* gdst, int gch) {
    const int tid = opaque_tid(), cg = tid & 63, rb = tid >> 6;
    if (cg >= ncg) return;
    int loff, pitch;
    if (cg < 32) { loff = OFF_X + cg * 16; pitch = PX; } else if (cg < 48) { loff = OFF_B + (cg - 32) * 16; pitch = PC; } else { loff = OFF_C + (cg - 48) * 16; pitch = PC; }
    const float w[4][8] = {{Rg.w[0][0].x, Rg.w[0][0].y, Rg.w[0][0].z, Rg.w[0][0].w, Rg.w[0][1].x, Rg.w[0][1].y, Rg.w[0][1].z, Rg.w[0][1].w},
                           {Rg.w[1][0].x, Rg.w[1][0].y, Rg.w[1][0].z, Rg.w[1][0].w, Rg.w[1][1].x, Rg.w[1][1].y, Rg.w[1][1].z, Rg.w[1][1].w},
                           {Rg.w[2][0].x, Rg.w[2][0].y, Rg.w[2][0].z, Rg.w[2][0].w, Rg.w[2][1].x, Rg.w[2][1].y, Rg.w[2][1].z, Rg.w[2][1].w},
                           {Rg.w[3][0].x, Rg.w[3][0].y, Rg.w[3][0].z, Rg.w[3][0].w, Rg.w[3][1].x, Rg.w[3][1].y, Rg.w[3][1].z, Rg.w[3][1].w}};
    const float bias[8] = {Rg.b[0].x, Rg.b[0].y, Rg.b[0].z, Rg.b[0].w, Rg.b[1].x, Rg.b[1].y, Rg.b[1].z, Rg.b[1].w};
    const int hd = cg >> 3;
    float r0[8], r1[8], r2[8], r3[8];
    unpack8(Rg.raw[0], r0); unpack8(Rg.raw[1], r1); unpack8(Rg.raw[2], r2);
#pragma unroll
    for (int i = 0; i < 8; ++i) {
        const int s = rb * 8 + i;
        unpack8(Rg.raw[3 + i], r3);
        float o[8];
        float sc = 1.f, sc2 = 1.f;
        if (cg < 32) { sc = xs0[hd * 64 + s]; if (xs1) sc2 = xs1[hd * 64 + s]; }
#pragma unroll
        for (int j = 0; j < 8; ++j) { const float a = bias[j] + w[0][j] * r0[j] + w[1][j] * r1[j] + w[2][j] * r2[j] + w[3][j] * r3[j]; o[j] = siluf_(a) * sc; }
        if (gdst) *(u32x4*)(gdst + (size_t)s * D + gch) = pack8(o);
        if (cg < 48) {
#pragma unroll
            for (int j = 0; j < 8; ++j) o[j] *= sc2;
            *(LAS u32x4*)(lds + loff + s * pitch) = pack8(o); }
#pragma unroll
        for (int j = 0; j < 8; ++j) { r0[j] = r1[j]; r1[j] = r2[j]; r2[j] = r3[j]; }
    }
}

__device__ __forceinline__ void phase_a(const Params& p, int layer, LAS unsigned char* lds, int c, int g) {
    const int tid = opaque_tid(), lane = tid & 63, wave = __builtin_amdgcn_readfirstlane(tid >> 6), fr = lane & 15, fq = lane >> 4;
    LAS float* cum = (LAS float*)(lds + OFF_CUM); LAS float* dtv = cum + 256; LAS float* wend = cum + 512;
    ConvRegs Rg; conv_load(p, layer, c, g, 64, Rg);
    gates(p, layer, lds, c, g, true);
    __syncthreads();
    { const int cg = tid & 63; const int ci = cg < 32 ? g * 256 + cg * 8 : (cg < 48 ? 1024 + g * 128 + (cg - 32) * 8 : 1536 + g * 128 + (cg - 48) * 8);
      conv_compute(lds, 64, dtv, wend, Rg, (bf16_t*)(p.ws + WS_U) + (size_t)(c * 64) * D, ci); }
    __syncthreads();
#ifdef PROBE_REFA
    for (int e = tid; e < 4 * 64 * 128; e += NTHREADS) {
        const int hh = e >> 13, pp_ = (e >> 7) & 63, k = e & 127;
        float a = 0.f;
        for (int s = 0; s < 64; ++s) a += bf2f(*(LAS bf16_t*)(lds + OFF_X + s * PX + (hh * 64 + pp_) * 2)) * bf2f(*(LAS bf16_t*)(lds + OFF_B + s * PC + k * 2));
        bf16_t* st2 = (bf16_t*)(p.ws + WS_ST_S) + ((size_t)c * 16 + 4 * g + hh) * 8192;
        st2[(((pp_ >> 4) * 4 + (k >> 5)) * 64 + ((k & 31) >> 3) * 16 + (pp_ & 15)) * 8 + (k & 7)] = f2bf(a);
    }
    __syncthreads();
    return;
#endif
    const int hd = wave >> 1;
    bf16_t* st = (bf16_t*)(p.ws + WS_ST_S) + ((size_t)c * 16 + 4 * g + hd) * 8192;
    bf16x8 xb[4][2];
#pragma unroll
    for (int pt = 0; pt < 4; ++pt)
#pragma unroll
        for (int ks = 0; ks < 2; ++ks) xb[pt][ks] = frag_tr<PX>(lds + OFF_X, ks * 32, hd * 64 + pt * 16, lane);
#pragma unroll
    for (int kk = 0; kk < 4; ++kk) {
        const int kt = 4 * (wave & 1) + kk;
        bf16x8 ba[2];
#pragma unroll
        for (int ks = 0; ks < 2; ++ks) ba[ks] = frag_tr<PC>(lds + OFF_B, ks * 32, kt * 16, lane);
#pragma unroll
        for (int pt = 0; pt < 4; ++pt) {
            f32x4 acc = (f32x4){0.f, 0.f, 0.f, 0.f};
#pragma unroll
            for (int ks = 0; ks < 2; ++ks) acc = mfma16(ba[ks], xb[pt][ks], acc);
            u32x2 o; o.x = cvt_pk_bf16(acc[0], acc[1]); o.y = cvt_pk_bf16(acc[2], acc[3]);
            *(u32x2*)(st + frag_off4<4>(pt * 16 + fr, kt * 16 + 4 * fq)) = o;
        }
    }
    __syncthreads();
}

__device__ __forceinline__ void phase_c(const Params& p, int layer, LAS unsigned char* lds, int c, int g) {
    const int tid = opaque_tid(), lane = tid & 63, wave = __builtin_amdgcn_readfirstlane(tid >> 6), fr = lane & 15, fq = lane >> 4;
    LAS float* cum = (LAS float*)(lds + OFF_CUM); LAS float* dtv = cum + 256;
    u32x4 xr[8];
    { const int cg = tid & 63, rb = tid >> 6; const int ci = cg < 32 ? g * 256 + cg * 8 : (cg < 48 ? 1024 + g * 128 + (cg - 32) * 8 : 1536 + g * 128 + (cg - 48) * 8);
      const bf16_t* xa = (const bf16_t*)(p.ws + WS_U) + (size_t)(c * 64 + rb * 8) * D + ci;
#pragma unroll
      for (int i = 0; i < 8; ++i) xr[i] = *(const u32x4*)(xa + (size_t)i * D); }
    const int hd = wave >> 1;
    bf16x8 sf[2][4];
    { const bf16_t* st = (const bf16_t*)(p.ws + WS_ST_S) + ((size_t)c * 16 + 4 * g + hd) * 8192;
#pragma unroll
      for (int pi = 0; pi < 2; ++pi)
#pragma unroll
          for (int ks = 0; ks < 4; ++ks) sf[pi][ks] = *(const bf16x8*)(st + (((2 * (wave & 1) + pi) * 4 + ks) * 64 + lane) * 8); }
    const bf16_t* proj = (const bf16_t*)(p.ws + WS_PROJ);
    u32x4 zr[4];
#pragma unroll
    for (int it = 0; it < 4; ++it) { const int item = it * 512 + tid; zr[it] = *(const u32x4*)(proj + (size_t)(c * 64 + (item >> 5)) * NPROJ + P_SZ + g * 256 + (item & 31) * 8); }
    gates(p, layer, lds, c, g, false);
    { const int cg = tid & 63, rb = tid >> 6; int loff, pitch;
      if (cg < 32) { loff = OFF_X + cg * 16; pitch = PX; } else if (cg < 48) { loff = OFF_B + (cg - 32) * 16; pitch = PC; } else { loff = OFF_C + (cg - 48) * 16; pitch = PC; }
#pragma unroll
      for (int i = 0; i < 8; ++i) *(LAS u32x4*)(lds + loff + (rb * 8 + i) * pitch) = xr[i]; }
    __syncthreads();
    for (int rp_ = 0; rp_ < SSD_RPT_S3; ++rp_)
    for (int ti = wave; ti < 12; ti += 8) {
        int tt, st; bool zero = false;
        if (ti < 10) { tt = ti < 1 ? 0 : ti < 3 ? 1 : ti < 6 ? 2 : 3; st = ti - (tt * (tt + 1)) / 2; }
        else { zero = true; tt = ti == 10 ? 0 : 2; st = tt + 1; }
        f32x4 acc = (f32x4){0.f, 0.f, 0.f, 0.f};
        if (!zero) {
#pragma unroll
            for (int ks = 0; ks < 4; ++ks) acc = mfma16(frag_row<PC>(lds + OFF_C, tt * 16, ks * 32, fr, fq), frag_row<PC>(lds + OFF_B, st * 16, ks * 32, fr, fq), acc);
        }
        const int s = st * 16 + fr, t0 = tt * 16 + 4 * fq;
        const bool diag = (tt == st);
#pragma unroll
        for (int hd = 0; hd < 4; ++hd) {
            const float cs = cum[hd * 64 + s];
            const f32x4 ct4 = *(const LAS f32x4*)(cum + hd * 64 + t0);
            f32x4 tm4 = (f32x4){0.f, 0.f, 0.f, 0.f};
            if (diag) { const f32x4 d4 = *(const LAS f32x4*)(dtv + hd * 64 + t0); const float dsk = p.dsk[layer * 16 + 4 * g + hd];
#pragma unroll
                for (int r = 0; r < 4; ++r) tm4[r] = d4[r] > 0.f ? dsk * __builtin_amdgcn_rcpf(d4[r]) : 0.f; }
#pragma unroll
            for (int r = 0; r < 4; ++r) {
                const int t = t0 + r;
                float v = acc[r] * __expf(ct4[r] - cs);
                v = (!zero && s <= t) ? v : 0.f;
                v += (diag && s == t) ? tm4[r] : 0.f;
                *(LAS bf16_t*)(lds + OFF_M + hd * 64 * PM + t * PM + s * 2) = f2bf(v);
            }
        }
    }
    __syncthreads();
    f32x4 y[2][4];
    for (int rp_ = 0; rp_ < SSD_RPT_S4; ++rp_)
    {
        bf16x8 xf[2][2];
#pragma unroll
        for (int pi = 0; pi < 2; ++pi) { const int pt = 2 * (wave & 1) + pi;
#pragma unroll
            for (int ks = 0; ks < 2; ++ks) xf[pi][ks] = frag_tr<PX>(lds + OFF_X, ks * 32, hd * 64 + pt * 16, lane); }
#pragma unroll
        for (int tt = 0; tt < 4; ++tt) {
            bf16x8 cf[4], mf[2];
#pragma unroll
            for (int ks = 0; ks < 4; ++ks) cf[ks] = frag_row<PC>(lds + OFF_C, tt * 16, ks * 32, fr, fq);
#pragma unroll
            for (int ks = 0; ks < 2; ++ks) mf[ks] = frag_row<PM>(lds + OFF_M + hd * 64 * PM, tt * 16, ks * 32, fr, fq);
            float ec[4];
#pragma unroll
            for (int r = 0; r < 4; ++r) ec[r] = __expf(cum[hd * 64 + tt * 16 + 4 * fq + r]);
#pragma unroll
            for (int pi = 0; pi < 2; ++pi) {
                f32x4 acc = (f32x4){0.f, 0.f, 0.f, 0.f};
#pragma unroll
                for (int ks = 0; ks < 4; ++ks) acc = mfma16(cf[ks], sf[pi][ks], acc);
#pragma unroll
                for (int r = 0; r < 4; ++r) acc[r] *= ec[r];
#ifdef PROBE_NOOFF
                acc = (f32x4){0.f, 0.f, 0.f, 0.f};
#endif
#ifndef PROBE_NODIAG
                acc = mfma16(mf[0], xf[pi][0], acc);
                if (tt >= 2) acc = mfma16(mf[1], xf[pi][1], acc);
#endif
                y[pi][tt] = acc;
            }
        }
    }
    __syncthreads();
    LAS float* Y = (LAS float*)(lds + OFF_B);
#pragma unroll
    for (int pi = 0; pi < 2; ++pi)
#pragma unroll
        for (int tt = 0; tt < 4; ++tt)
#pragma unroll
            for (int r = 0; r < 4; ++r) Y[(tt * 16 + 4 * fq + r) * PY + hd * 64 + (2 * (wave & 1) + pi) * 16 + fr] = y[pi][tt][r];
    __syncthreads();
    bf16_t* mixed = (bf16_t*)(p.ws + WS_MIXED);
    const float* nw = p.ssnw + (size_t)layer * 1024 + g * 256;
    for (int rp_ = 0; rp_ < SSD_RPT_EPI; ++rp_)
#pragma unroll
    for (int it = 0; it < 4; ++it) {
        const int item = it * 512 + tid, rloc = item >> 5, cgp = item & 31, row = c * 64 + rloc;
        float z[8], v[8];
        unpack8(zr[it], z);
        float ss = 0.f;
#pragma unroll
        for (int j = 0; j < 8; ++j) { v[j] = Y[rloc * PY + cgp * 8 + j] * siluf_(z[j]); ss += v[j] * v[j]; }
        ss = sum32_dpp(ss, lane);
        const float rs = rsqrtf(ss * (1.f / 256.f) + EPS);
        const f32x4 w0 = *(const f32x4*)(nw + cgp * 8), w1 = *(const f32x4*)(nw + cgp * 8 + 4);
        v[0] *= rs * w0.x; v[1] *= rs * w0.y; v[2] *= rs * w0.z; v[3] *= rs * w0.w; v[4] *= rs * w1.x; v[5] *= rs * w1.y; v[6] *= rs * w1.z; v[7] *= rs * w1.w;
#ifdef PROBE_ZERO
        for (int j = 0; j < 8; ++j) v[j] = 0.f;
#endif
        *(u32x4*)(mixed + (size_t)row * D + 1024 + g * 256 + cgp * 8) = pack8(v);
    }
    __syncthreads();
}

__device__ __forceinline__ void scan_item(const Params& p, int item) {
    const int e8 = item & 1023, bh = __builtin_amdgcn_readfirstlane(item >> 10), b = bh >> 4, hd = bh & 15;
    bf16_t* base = (bf16_t*)(p.ws + WS_ST_S) + ((size_t)(b * CPB) * 16 + hd) * 8192 + e8 * 8;
    const float* dec = (const float*)(p.ws + WS_DEC_S) + (b * CPB) * 16 + hd;
    u32x4 loc[CPB];
#pragma unroll
    for (int n = 0; n < CPB; ++n) loc[n] = SCAN_LD((const u32x4*)(base + (size_t)n * 16 * 8192));
    float S[8];
#pragma unroll
    for (int j = 0; j < 8; ++j) S[j] = 0.f;
#pragma unroll
    for (int n = 0; n < CPB; ++n) {
        const float d = dec[n * 16];
        float l[8]; unpack8(loc[n], l);
        *(u32x4*)(base + (size_t)n * 16 * 8192) = pack8(S);
#pragma unroll
        for (int j = 0; j < 8; ++j) S[j] = d * S[j] + l[j];
    }
}
}
namespace mls {
constexpr int PQ = 144, PV = 304, PP = 144;
constexpr int OFF_Q = 0, OFF_K = 64 * PQ, OFF_V = OFF_K + 64 * PQ, OFF_P = OFF_V + 64 * PV, OFF_G = OFF_P + 64 * PP, OFF_END = OFF_G + 6 * 64 * 4;
constexpr int PY = 148;
constexpr int OFF_Y = OFF_END;
constexpr float NEGV = -1e30f;

__device__ __forceinline__ void gates(const Params& p, int layer, LAS unsigned char* lds, int c, int h, bool phaseA) {
    const int tid = opaque_tid(), lane = tid & 63, wave = __builtin_amdgcn_readfirstlane(tid >> 6);
    LAS float* G = (LAS float*)(lds + OFF_G);
    if (wave == 0) {
        const int row = c * 64 + lane, pp = row % PB;
        const float* gates = (const float*)(p.ws + WS_GATES);
        float li = NEGV, lf = 0.f;
        if (pp >= LEADP) {
            const float ip = gates[(size_t)row * NGATE + h] + p.mbi[layer * 4 + h], fp = gates[(size_t)row * NGATE + 4 + h] + p.mbf[layer * 4 + h];
            li = 15.f * tanhf(ip * (1.f / 15.f)); lf = logsigmoidf_(15.f * tanhf(fp * (1.f / 15.f)));
        }
        const float cs = wave_scan_incl(lf, lane);
        const float last = __shfl(cs, 63);
        G[lane] = li; G[64 + lane] = cs;
        if (phaseA) {
            const float te = last - cs + li;
            const float ml = wave_max(te);
            G[128 + lane] = __expf(te - ml);
            if (lane == 0) { float* sc = (float*)(p.ws + WS_SC_M) + ((size_t)c * 4 + h) * 2; sc[0] = ml; sc[1] = last; }
        } else {
            const float mprev = ((const float*)(p.ws + WS_MP_M))[(size_t)c * 4 + h];
            const float mintra = cs + wave_scan_max_incl(li - cs, lane);
            const float inter = cs + mprev;
            const float mt = fmaxf(inter, mintra);
            G[128 + lane] = mt; G[192 + lane] = __expf(inter - mt); G[256 + lane] = __expf(-mt);
        }
    }
}

__device__ __forceinline__ void phase_a(const Params& p, int layer, LAS unsigned char* lds, int c, int h) {
    const int tid = opaque_tid(), lane = tid & 63, wave = __builtin_amdgcn_readfirstlane(tid >> 6), fr = lane & 15, fq = lane >> 4;
    LAS float* G = (LAS float*)(lds + OFF_G);
    gates(p, layer, lds, c, h, true);
    __syncthreads();
    const bf16_t* proj = (const bf16_t*)(p.ws + WS_PROJ) + (size_t)(c * 64) * NPROJ;
    {
        for (int item = tid; item < 64 * 24; item += NTHREADS) {
            const int s = item / 24, ch = item % 24;
            if (ch < 8) { float f[8]; unpack8(*(const u32x4*)(proj + (size_t)s * NPROJ + P_MK + h * 64 + ch * 8), f); const float w = G[128 + s];
#pragma unroll
                for (int j = 0; j < 8; ++j) f[j] *= w;
                *(LAS u32x4*)(lds + OFF_K + s * PQ + ch * 16) = pack8(f); }
            else { *(LAS u32x4*)(lds + OFF_V + s * PV + (ch - 8) * 16) = *(const u32x4*)(proj + (size_t)s * NPROJ + P_MV + h * 128 + (ch - 8) * 8); }
        }
    }
    __syncthreads();
    bf16_t* st = (bf16_t*)(p.ws + WS_ST_M) + ((size_t)c * 4 + h) * 8192;
    {
        const int et = wave;
        bf16x8 vb[2];
#pragma unroll
        for (int ks = 0; ks < 2; ++ks) vb[ks] = frag_tr<PV>(lds + OFF_V, ks * 32, et * 16, lane);
#pragma unroll
        for (int dt = 0; dt < 4; ++dt) {
            f32x4 acc = (f32x4){0.f, 0.f, 0.f, 0.f};
#pragma unroll
            for (int ks = 0; ks < 2; ++ks) acc = mfma16(frag_tr<PQ>(lds + OFF_K, ks * 32, dt * 16, lane), vb[ks], acc);
            u32x2 o; o.x = cvt_pk_bf16(acc[0], acc[1]); o.y = cvt_pk_bf16(acc[2], acc[3]);
            *(u32x2*)(st + frag_off4<2>(et * 16 + fr, dt * 16 + 4 * fq)) = o;
        }
    }
    if (tid < 64) {
        float s = 0.f;
        for (int r = 0; r < 64; ++r) s += bf2f(*(LAS bf16_t*)(lds + OFF_K + r * PQ + tid * 2));
        ((float*)(p.ws + WS_NV_M))[((size_t)c * 4 + h) * 64 + tid] = s;
    }
    __syncthreads();
}

__device__ __forceinline__ void phase_c(const Params& p, int layer, LAS unsigned char* lds, int c, int h) {
    const int tid = opaque_tid(), lane = tid & 63, wave = __builtin_amdgcn_readfirstlane(tid >> 6), fr = lane & 15, fq = lane >> 4;
    LAS float* G = (LAS float*)(lds + OFF_G);
    gates(p, layer, lds, c, h, false);
    const bf16_t* proj = (const bf16_t*)(p.ws + WS_PROJ) + (size_t)(c * 64) * NPROJ;
    {
        for (int item = tid; item < 64 * 34; item += NTHREADS) {
            const int s = item / 34, ch = item % 34;
            if (ch < 8) { float f[8]; unpack8(*(const u32x4*)(proj + (size_t)s * NPROJ + P_MQ + h * 64 + ch * 8), f);
#pragma unroll
                for (int j = 0; j < 8; ++j) f[j] *= 0.125f;
                *(LAS u32x4*)(lds + OFF_Q + s * PQ + ch * 16) = pack8(f); }
            else if (ch < 16) *(LAS u32x4*)(lds + OFF_K + s * PQ + (ch - 8) * 16) = *(const u32x4*)(proj + (size_t)s * NPROJ + P_MK + h * 64 + (ch - 8) * 8);
            else if (ch < 32) *(LAS u32x4*)(lds + OFF_V + s * PV + (ch - 16) * 16) = *(const u32x4*)(proj + (size_t)s * NPROJ + P_MV + h * 128 + (ch - 16) * 8);
            else { u32x4 o; o.x = (ch == 32) ? 0x00003f80u : 0u; o.y = 0u; o.z = 0u; o.w = 0u; *(LAS u32x4*)(lds + OFF_V + s * PV + 256 + (ch - 32) * 16) = o; }
        }
    }
    __syncthreads();
    for (int ti = wave; ti < 12; ti += 8) {
        int tt, st; bool zero = false;
        if (ti < 10) { tt = ti < 1 ? 0 : ti < 3 ? 1 : ti < 6 ? 2 : 3; st = ti - (tt * (tt + 1)) / 2; }
        else { zero = true; tt = ti == 10 ? 0 : 2; st = tt + 1; }
        f32x4 acc = (f32x4){0.f, 0.f, 0.f, 0.f};
        if (!zero) {
#pragma unroll
            for (int ks = 0; ks < 2; ++ks) acc = mfma16(frag_row<PQ>(lds + OFF_Q, tt * 16, ks * 32, fr, fq), frag_row<PQ>(lds + OFF_K, st * 16, ks * 32, fr, fq), acc);
        }
        const int s = st * 16 + fr, t0 = tt * 16 + 4 * fq;
        const float gs = G[s] - G[64 + s];
        const f32x4 ct4 = *(const LAS f32x4*)(G + 64 + t0), mt4 = *(const LAS f32x4*)(G + 128 + t0);
#pragma unroll
        for (int r = 0; r < 4; ++r) {
            const int t = t0 + r;
            float v = acc[r] * __expf(ct4[r] + gs - mt4[r]);
            v = (!zero && s <= t) ? v : 0.f;
            *(LAS bf16_t*)(lds + OFF_P + t * PP + s * 2) = f2bf(v);
        }
    }
    __syncthreads();
    const bf16_t* st = (const bf16_t*)(p.ws + WS_ST_M) + ((size_t)c * 4 + h) * 8192;
    const float* nprev = (const float*)(p.ws + WS_NV_M) + ((size_t)c * 4 + h) * 64;
    f32x4 y[4], yd = (f32x4){0.f, 0.f, 0.f, 0.f};
    {
        bf16x8 cf[2], vf[2];
#pragma unroll
        for (int ks = 0; ks < 2; ++ks) { cf[ks] = *(const bf16x8*)(st + ((wave * 2 + ks) * 64 + lane) * 8); vf[ks] = frag_tr<PV>(lds + OFF_V, ks * 32, wave * 16, lane); }
#pragma unroll
        for (int tt = 0; tt < 4; ++tt) {
            f32x4 acc = (f32x4){0.f, 0.f, 0.f, 0.f};
#pragma unroll
            for (int ks = 0; ks < 2; ++ks) acc = mfma16(frag_row<PQ>(lds + OFF_Q, tt * 16, ks * 32, fr, fq), cf[ks], acc);
#pragma unroll
            for (int r = 0; r < 4; ++r) acc[r] *= G[192 + tt * 16 + 4 * fq + r];
            acc = mfma16(frag_row<PP>(lds + OFF_P, tt * 16, 0, fr, fq), vf[0], acc);
            if (tt >= 2) acc = mfma16(frag_row<PP>(lds + OFF_P, tt * 16, 32, fr, fq), vf[1], acc);
            y[tt] = acc;
        }
        if (wave < 4) {
            const int tt = wave;
            bf16x8 nf[2], of[2];
#pragma unroll
            for (int ks = 0; ks < 2; ++ks) {
                float f[8];
#pragma unroll
                for (int j = 0; j < 8; ++j) f[j] = (fr == 0) ? nprev[ks * 32 + 8 * fq + j] : 0.f;
                const u32x4 w = pack8(f); nf[ks] = __builtin_bit_cast(bf16x8, w);
                of[ks] = frag_tr<PV>(lds + OFF_V, ks * 32, 128, lane);
            }
            f32x4 acc = (f32x4){0.f, 0.f, 0.f, 0.f};
#pragma unroll
            for (int ks = 0; ks < 2; ++ks) acc = mfma16(frag_row<PQ>(lds + OFF_Q, tt * 16, ks * 32, fr, fq), nf[ks], acc);
#pragma unroll
            for (int r = 0; r < 4; ++r) acc[r] *= G[192 + tt * 16 + 4 * fq + r];
            acc = mfma16(frag_row<PP>(lds + OFF_P, tt * 16, 0, fr, fq), of[0], acc);
            if (tt >= 2) acc = mfma16(frag_row<PP>(lds + OFF_P, tt * 16, 32, fr, fq), of[1], acc);
            yd = acc;
        }
    }
    LAS float* Y = (LAS float*)(lds + OFF_Y);
#pragma unroll
    for (int tt = 0; tt < 4; ++tt)
#pragma unroll
        for (int r = 0; r < 4; ++r) Y[(tt * 16 + 4 * fq + r) * PY + wave * 16 + fr] = y[tt][r];
    if (wave < 4) {
#pragma unroll
        for (int r = 0; r < 4; ++r) Y[(wave * 16 + 4 * fq + r) * PY + 128 + fr] = yd[r];
    }
    __syncthreads();
    bf16_t* mixed = (bf16_t*)(p.ws + WS_MIXED);
    const float* nw = p.mlnw + (size_t)layer * 512 + h * 128;
#pragma unroll
    for (int it = 0; it < 2; ++it) {
        const int item = it * 512 + tid, rloc = item >> 4, cgp = item & 15, row = c * 64 + rloc;
        const float den = Y[rloc * PY + 128];
        const float inv = 1.f / fmaxf(fabsf(den), G[256 + rloc]);
        float o[8], v[8];
        unpack8(*(const u32x4*)(proj + (size_t)rloc * NPROJ + P_MO + h * 128 + cgp * 8), o);
        float ss = 0.f;
#pragma unroll
        for (int j = 0; j < 8; ++j) { v[j] = Y[rloc * PY + cgp * 8 + j] * inv; ss += v[j] * v[j]; }
        ss = sum16_dpp(ss);
        const float rs = rsqrtf(ss * (1.f / 128.f) + EPS);
        const f32x4 w0 = *(const f32x4*)(nw + cgp * 8), w1 = *(const f32x4*)(nw + cgp * 8 + 4);
        const float wv[8] = {w0.x, w0.y, w0.z, w0.w, w1.x, w1.y, w1.z, w1.w};
#pragma unroll
        for (int j = 0; j < 8; ++j) v[j] *= rs * wv[j] * sigmoidf_(o[j]);
        *(u32x4*)(mixed + (size_t)row * D + 512 + h * 128 + cgp * 8) = pack8(v);
    }
    __syncthreads();
}

__device__ __forceinline__ void scan_item(const Params& p, int item) {
    const int bh = __builtin_amdgcn_readfirstlane(item / 1088), sub = item - bh * 1088, b = bh >> 2, h = bh & 3;
    const float* sc = (const float*)(p.ws + WS_SC_M) + ((size_t)(b * CPB) * 4 + h) * 2;
    float m_ = 0.f;
    if (sub < 1024) {
        bf16_t* base = (bf16_t*)(p.ws + WS_ST_M) + ((size_t)(b * CPB) * 4 + h) * 8192 + sub * 8;
        u32x4 loc[CPB];
#pragma unroll
        for (int n = 0; n < CPB; ++n) loc[n] = SCAN_LD((const u32x4*)(base + (size_t)n * 4 * 8192));
        float S[8];
#pragma unroll
        for (int j = 0; j < 8; ++j) S[j] = 0.f;
#pragma unroll
        for (int n = 0; n < CPB; ++n) {
            const float ml = sc[n * 8], tot = sc[n * 8 + 1];
            const float mn = fmaxf(tot + m_, ml), a_ = __expf(tot + m_ - mn), s_ = __expf(ml - mn);
            float l[8]; unpack8(loc[n], l);
            *(u32x4*)(base + (size_t)n * 4 * 8192) = pack8(S);
#pragma unroll
            for (int j = 0; j < 8; ++j) S[j] = a_ * S[j] + s_ * l[j];
            m_ = mn;
        }
    } else {
        const int d = sub - 1024;
        float* nv = (float*)(p.ws + WS_NV_M) + ((size_t)(b * CPB) * 4 + h) * 64 + d;
        float* mp = (float*)(p.ws + WS_MP_M) + (size_t)(b * CPB) * 4 + h;
        float loc[CPB];
#pragma unroll
        for (int n = 0; n < CPB; ++n) loc[n] = nv[(size_t)n * 4 * 64];
        float S = 0.f;
#pragma unroll
        for (int n = 0; n < CPB; ++n) {
            const float ml = sc[n * 8], tot = sc[n * 8 + 1];
            const float mn = fmaxf(tot + m_, ml), a_ = __expf(tot + m_ - mn), s_ = __expf(ml - mn);
            nv[(size_t)n * 4 * 64] = S; S = a_ * S + s_ * loc[n];
            if (d == 0) mp[n * 4] = m_;
            m_ = mn;
        }
    }
}
}
namespace hgr {
constexpr int PF = 132;
constexpr int PT = 272;
constexpr int PP = 144;
constexpr int OFF_X = 0, X_BYTES = 2 * 64 * PT, OFF_CUM = OFF_X + X_BYTES, OFF_KS = OFF_CUM + 64 * PF * 4, OFF_V = OFF_KS + 10 * 16 * PT, OFF_P = OFF_V + 64 * PT, OFF_END = OFF_P + 64 * PP;
static_assert(64 * PF * 4 <= X_BYTES, "LF fits region X");
static_assert(OFF_END <= 147456 - 64, "hgrn2 LDS");
constexpr int OFF_QS = OFF_X, OFF_QC = OFF_X + 64 * PT;

__device__ __forceinline__ float lb_of(const Params& p, int layer, int ch) {
    if (layer == 0) return 0.f;
    const float a0 = p.lbl[ch], a1 = p.lbl[512 + ch];
    return __builtin_amdgcn_rcpf(1.f + __expf(a0 - a1));
}
__device__ __forceinline__ void gates(const Params& p, int layer, LAS unsigned char* lds, int c, int h) {
    const int tid = opaque_tid();
    LAS float* LF = (LAS float*)(lds + OFF_X); LAS float* CUM = (LAS float*)(lds + OFF_CUM);
    const bf16_t* proj = (const bf16_t*)(p.ws + WS_PROJ) + (size_t)(c * 64) * NPROJ;
#pragma unroll
    for (int it = 0; it < 2; ++it) {
        const int item = it * 512 + tid, s = item >> 4, cg = item & 15;
        const int pp = (c * 64 + s) % PB;
        float z[8], lf[8];
        unpack8(*(const u32x4*)(proj + (size_t)s * NPROJ + P_HF + h * 128 + cg * 8), z);
#pragma unroll
        for (int j = 0; j < 8; ++j) {
            const float lb = lb_of(p, layer, h * 128 + cg * 8 + j);
            const float f = lb + (1.f - lb) * sigmoidf_(z[j]);
            lf[j] = pp >= LEADP ? __logf(f) : 0.f;
        }
        *(LAS f32x4*)(LF + s * PF + cg * 8) = (f32x4){lf[0], lf[1], lf[2], lf[3]};
        *(LAS f32x4*)(LF + s * PF + cg * 8 + 4) = (f32x4){lf[4], lf[5], lf[6], lf[7]};
    }
    __syncthreads();
    {
        const int d = tid & 127, sb = tid >> 7;
        float run = 0.f;
#pragma unroll
        for (int i = 0; i < 16; ++i) { run += LF[(sb * 16 + i) * PF + d]; CUM[(sb * 16 + i) * PF + d] = run; }
    }
    __syncthreads();
    {
        const int d = tid & 127, sb = tid >> 7;
        float pre = 0.f;
        for (int q = 0; q < sb; ++q) pre += CUM[(q * 16 + 15) * PF + d];
        __syncthreads();
#pragma unroll
        for (int i = 0; i < 16; ++i) { const int s = sb * 16 + i; CUM[s * PF + d] += pre; const int pp = (c * 64 + s) % PB; LF[s * PF + d] = pp >= LEADP ? 1.f - __expf(LF[s * PF + d]) : 0.f; }
    }
    __syncthreads();
}
__device__ __forceinline__ void stage_v(const Params& p, LAS unsigned char* lds, int c, int h) {
    const int tid = opaque_tid();
    const bf16_t* proj = (const bf16_t*)(p.ws + WS_PROJ) + (size_t)(c * 64) * NPROJ;
#pragma unroll
    for (int it = 0; it < 2; ++it) { const int item = it * 512 + tid, s = item >> 4, cg = item & 15;
        *(LAS u32x4*)(lds + OFF_V + s * PT + cg * 16) = *(const u32x4*)(proj + (size_t)s * NPROJ + P_HI + h * 128 + cg * 8); }
}

__device__ __forceinline__ void phase_a(const Params& p, int layer, LAS unsigned char* lds, int c, int h) {
    const int tid = opaque_tid(), lane = tid & 63, wave = __builtin_amdgcn_readfirstlane(tid >> 6), fr = lane & 15, fq = lane >> 4;
    LAS float* KF = (LAS float*)(lds + OFF_X); LAS float* CUM = (LAS float*)(lds + OFF_CUM);
    stage_v(p, lds, c, h);
    gates(p, layer, lds, c, h);
#pragma unroll
    for (int it = 0; it < 2; ++it) {
        const int item = it * 512 + tid, s = item >> 4, cg = item & 15;
        float o[8];
#pragma unroll
        for (int hh = 0; hh < 2; ++hh) { const int d = cg * 8 + 4 * hh;
            const f32x4 kf = *(const LAS f32x4*)(KF + s * PF + d), cl = *(const LAS f32x4*)(CUM + 63 * PF + d), cs = *(const LAS f32x4*)(CUM + s * PF + d);
            o[4 * hh + 0] = kf.x * __expf(cl.x - cs.x); o[4 * hh + 1] = kf.y * __expf(cl.y - cs.y); o[4 * hh + 2] = kf.z * __expf(cl.z - cs.z); o[4 * hh + 3] = kf.w * __expf(cl.w - cs.w); }
        *(LAS u32x4*)(lds + OFF_KS + s * PT + cg * 16) = pack8(o);
    }
    if (tid < 128) ((float*)(p.ws + WS_DEC_H))[((size_t)c * 4 + h) * 128 + tid] = __expf(CUM[63 * PF + tid]);
    __syncthreads();
    bf16_t* st = (bf16_t*)(p.ws + WS_ST_H) + ((size_t)c * 4 + h) * 16384;
    {
        const int et = wave;
        bf16x8 vb[2];
#pragma unroll
        for (int ks = 0; ks < 2; ++ks) vb[ks] = frag_tr<PT>(lds + OFF_V, ks * 32, et * 16, lane);
#pragma unroll
        for (int dt = 0; dt < 8; ++dt) {
            f32x4 acc = (f32x4){0.f, 0.f, 0.f, 0.f};
#pragma unroll
            for (int ks = 0; ks < 2; ++ks) acc = mfma16(frag_tr<PT>(lds + OFF_KS, ks * 32, dt * 16, lane), vb[ks], acc);
            u32x2 o; o.x = cvt_pk_bf16(acc[0], acc[1]); o.y = cvt_pk_bf16(acc[2], acc[3]);
            *(u32x2*)(st + frag_off4<4>(et * 16 + fr, dt * 16 + 4 * fq)) = o;
        }
    }
    __syncthreads();
}

__device__ __forceinline__ void phase_c(const Params& p, int layer, LAS unsigned char* lds, int c, int h) {
    const int tid = opaque_tid(), lane = tid & 63, wave = __builtin_amdgcn_readfirstlane(tid >> 6), fr = lane & 15, fq = lane >> 4;
    LAS float* KF = (LAS float*)(lds + OFF_X); LAS float* CUM = (LAS float*)(lds + OFF_CUM);
    const bf16_t* proj = (const bf16_t*)(p.ws + WS_PROJ) + (size_t)(c * 64) * NPROJ;
    stage_v(p, lds, c, h);
    gates(p, layer, lds, c, h);
    for (int item = tid; item < 10 * 16 * 16; item += NTHREADS) {
        const int sbi = item >> 8, rs = (item >> 4) & 15, cg = item & 15;
        const int j = sbi < 1 ? 0 : sbi < 3 ? 1 : sbi < 6 ? 2 : 3, i = sbi - (j * (j + 1)) / 2, s = i * 16 + rs;
        float o[8];
#pragma unroll
        for (int hh = 0; hh < 2; ++hh) { const int d = cg * 8 + 4 * hh;
            const f32x4 kf = *(const LAS f32x4*)(KF + s * PF + d), cs = *(const LAS f32x4*)(CUM + s * PF + d);
            f32x4 rf = (f32x4){0.f, 0.f, 0.f, 0.f}; if (j > 0) rf = *(const LAS f32x4*)(CUM + (16 * j - 1) * PF + d);
            o[4 * hh + 0] = kf.x * __expf(rf.x - cs.x); o[4 * hh + 1] = kf.y * __expf(rf.y - cs.y); o[4 * hh + 2] = kf.z * __expf(rf.z - cs.z); o[4 * hh + 3] = kf.w * __expf(rf.w - cs.w); }
        *(LAS u32x4*)(lds + OFF_KS + (sbi * 16 + rs) * PT + cg * 16) = pack8(o);
    }
    __syncthreads();
#pragma unroll
    for (int it = 0; it < 2; ++it) {
        const int item = it * 512 + tid, t = item >> 4, cg = item & 15, j = t >> 4;
        float q[8], a[8], b[8];
        unpack8(*(const u32x4*)(proj + (size_t)t * NPROJ + P_HQ + h * 128 + cg * 8), q);
#pragma unroll
        for (int hh = 0; hh < 2; ++hh) { const int d = cg * 8 + 4 * hh;
            const f32x4 cu = *(const LAS f32x4*)(CUM + t * PF + d);
            f32x4 rf = (f32x4){0.f, 0.f, 0.f, 0.f}; if (j > 0) rf = *(const LAS f32x4*)(CUM + (16 * j - 1) * PF + d);
            const float cuv[4] = {cu.x, cu.y, cu.z, cu.w}, rfv[4] = {rf.x, rf.y, rf.z, rf.w};
#pragma unroll
            for (int k = 0; k < 4; ++k) { const float qq = q[4 * hh + k] * 0.08838834764831845f; a[4 * hh + k] = qq * __expf(cuv[k] - rfv[k]); b[4 * hh + k] = qq * __expf(cuv[k]); } }
        *(LAS u32x4*)(lds + OFF_QS + t * PT + cg * 16) = pack8(a);
        *(LAS u32x4*)(lds + OFF_QC + t * PT + cg * 16) = pack8(b);
    }
    __syncthreads();
    for (int ti = wave; ti < 12; ti += 8) {
        int tt, st; bool zero = false;
        if (ti < 10) { tt = ti < 1 ? 0 : ti < 3 ? 1 : ti < 6 ? 2 : 3; st = ti - (tt * (tt + 1)) / 2; }
        else { zero = true; tt = ti == 10 ? 0 : 2; st = tt + 1; }
        f32x4 acc = (f32x4){0.f, 0.f, 0.f, 0.f};
        if (!zero) {
#pragma unroll
            for (int ks = 0; ks < 4; ++ks) acc = mfma16(frag_row<PT>(lds + OFF_QS, tt * 16, ks * 32, fr, fq), frag_row<PT>(lds + OFF_KS + ti * 16 * PT, 0, ks * 32, fr, fq), acc);
        }
        const int s = st * 16 + fr;
#pragma unroll
        for (int r = 0; r < 4; ++r) {
            const int t = tt * 16 + 4 * fq + r;
            const float v = (!zero && s <= t) ? acc[r] : 0.f;
            *(LAS bf16_t*)(lds + OFF_P + t * PP + s * 2) = f2bf(v);
        }
    }
    __syncthreads();
    const bf16_t* st = (const bf16_t*)(p.ws + WS_ST_H) + ((size_t)c * 4 + h) * 16384;
    f32x4 y[4];
    {
        bf16x8 sf[4], vf[2];
#pragma unroll
        for (int ks = 0; ks < 4; ++ks) sf[ks] = *(const bf16x8*)(st + ((wave * 4 + ks) * 64 + lane) * 8);
#pragma unroll
        for (int ks = 0; ks < 2; ++ks) vf[ks] = frag_tr<PT>(lds + OFF_V, ks * 32, wave * 16, lane);
#pragma unroll
        for (int tt = 0; tt < 4; ++tt) {
            f32x4 acc = (f32x4){0.f, 0.f, 0.f, 0.f};
#pragma unroll
            for (int ks = 0; ks < 4; ++ks) acc = mfma16(frag_row<PT>(lds + OFF_QC, tt * 16, ks * 32, fr, fq), sf[ks], acc);
            acc = mfma16(frag_row<PP>(lds + OFF_P, tt * 16, 0, fr, fq), vf[0], acc);
            if (tt >= 2) acc = mfma16(frag_row<PP>(lds + OFF_P, tt * 16, 32, fr, fq), vf[1], acc);
            y[tt] = acc;
        }
    }
    LAS float* Y = (LAS float*)(lds + OFF_CUM);
#pragma unroll
    for (int tt = 0; tt < 4; ++tt)
#pragma unroll
        for (int r = 0; r < 4; ++r) Y[(tt * 16 + 4 * fq + r) * PF + wave * 16 + fr] = y[tt][r];
    __syncthreads();
    bf16_t* mixed = (bf16_t*)(p.ws + WS_MIXED);
    const float* nw = p.hgnw + (size_t)layer * 512 + h * 128;
#pragma unroll
    for (int it = 0; it < 2; ++it) {
        const int item = it * 512 + tid, rloc = item >> 4, cgp = item & 15, row = c * 64 + rloc;
        float g[8], v[8];
        unpack8(*(const u32x4*)(proj + (size_t)rloc * NPROJ + P_HG + h * 128 + cgp * 8), g);
        float ss = 0.f;
#pragma unroll
        for (int j = 0; j < 8; ++j) { v[j] = Y[rloc * PF + cgp * 8 + j]; ss += v[j] * v[j]; }
        ss = sum16_dpp(ss);
        const float rs = rsqrtf(ss * (1.f / 128.f) + EPS);
        const f32x4 w0 = *(const f32x4*)(nw + cgp * 8), w1 = *(const f32x4*)(nw + cgp * 8 + 4);
        const float wv[8] = {w0.x, w0.y, w0.z, w0.w, w1.x, w1.y, w1.z, w1.w};
#pragma unroll
        for (int j = 0; j < 8; ++j) v[j] *= rs * wv[j] * siluf_(g[j]);
        *(u32x4*)(mixed + (size_t)row * D + h * 128 + cgp * 8) = pack8(v);
    }
    __syncthreads();
}

__device__ __forceinline__ void scan_item(const Params& p, int item) {
    const int e8 = item & 2047, bh = __builtin_amdgcn_readfirstlane(item >> 11), b = bh >> 2, h = bh & 3;
    const int ks = (e8 >> 6) & 3, fql = (e8 & 63) >> 4, d0 = ks * 32 + 8 * fql;
    bf16_t* base = (bf16_t*)(p.ws + WS_ST_H) + ((size_t)(b * CPB) * 4 + h) * 16384 + e8 * 8;
    const float* dec = (const float*)(p.ws + WS_DEC_H) + ((size_t)(b * CPB) * 4 + h) * 128 + d0;
    float S[8];
#pragma unroll
    for (int j = 0; j < 8; ++j) S[j] = 0.f;
#pragma unroll 1
    for (int g = 0; g < 3; ++g) {
        u32x4 loc[11]; f32x4 da[11], db[11];
#pragma unroll
        for (int i = 0; i < 11; ++i) { const int n = g * 11 + i; loc[i] = SCAN_LD((const u32x4*)(base + (size_t)n * 4 * 16384)); da[i] = *(const f32x4*)(dec + (size_t)n * 4 * 128); db[i] = *(const f32x4*)(dec + (size_t)n * 4 * 128 + 4); }
#pragma unroll
        for (int i = 0; i < 11; ++i) { const int n = g * 11 + i;
            const float dd[8] = {da[i].x, da[i].y, da[i].z, da[i].w, db[i].x, db[i].y, db[i].z, db[i].w};
            float l[8]; unpack8(loc[i], l);
            *(u32x4*)(base + (size_t)n * 4 * 16384) = pack8(S);
#pragma unroll
            for (int j = 0; j < 8; ++j) S[j] = dd[j] * S[j] + l[j]; }
    }
}
}
#ifndef NEW_H
#define NEW_H 1
#endif
#ifndef NEW_M
#define NEW_M 1
#endif
#ifndef NEW_S
#define NEW_S 1
#endif
#ifndef MIXRPT_SC
#define MIXRPT_SC 1
#endif
#ifndef MIXRPT_MC
#define MIXRPT_MC 1
#endif
#ifndef MIXRPT_HC
#define MIXRPT_HC 1
#endif
#ifndef MIXRPT_SA
#define MIXRPT_SA 1
#endif
#ifndef MIXRPT_MA
#define MIXRPT_MA 1
#endif
#ifndef MIXRPT_HA
#define MIXRPT_HA 1
#endif
template <bool PHASE_C>
__device__ __forceinline__ void phase_mix(const Params& p, int layer, LAS unsigned char* lds) {
    for (int u = blockIdx.x; u < 3 * NCH * 4; u += gridDim.x) {
        const int type = u % 3, idx = u / 3, c = idx >> 2, sub = idx & 3;
        if (type == 0) { for (int rp = 0; rp < (PHASE_C ? MIXRPT_SC : MIXRPT_SA); ++rp) { if (PHASE_C) ssd::phase_c(p, layer, lds, c, sub); else ssd::phase_a(p, layer, lds, c, sub); } }
        else if (type == 1) { for (int rp = 0; rp < (PHASE_C ? MIXRPT_MC : MIXRPT_MA); ++rp) { if (PHASE_C) mls::phase_c(p, layer, lds, c, sub); else mls::phase_a(p, layer, lds, c, sub); } }
        else { for (int rp = 0; rp < (PHASE_C ? MIXRPT_HC : MIXRPT_HA); ++rp) { if (PHASE_C) hgr::phase_c(p, layer, lds, c, sub); else hgr::phase_a(p, layer, lds, c, sub); } }
    }
}
__device__ __forceinline__ void phase_scan(const Params& p) {
    constexpr int N_S = NB * 16 * 1024, N_M = NB * 4 * 1088, N_H = NB * 4 * 2048;
    for (int gid = blockIdx.x * NTHREADS + opaque_tid(); gid < N_S + N_M + N_H; gid += gridDim.x * NTHREADS) {
        if (gid < N_S) { if (NEW_S) ssd::scan_item(p, gid); }
        else if (gid < N_S + N_M) { if (NEW_M) mls::scan_item(p, gid - N_S); }
        else { if (NEW_H) hgr::scan_item(p, gid - N_S - N_M); }
    }
}
struct EpiResid {
    static constexpr bool PERM = false;
    const float* base; float* out; int ldc;
    __device__ __forceinline__ void operator()(const f32x4 (&acc)[2][2][4][2], const pg8::GU& u, int wr, int wc, int fr, int fq) const {
        const int row0 = u.r0 + wr * 64 + fr, col0 = u.c0 + wc * 32 + 4 * fq;
#pragma unroll
        for (int ai = 0; ai < 2; ++ai) if (ai == 0 || !u.half)
#pragma unroll
            for (int m = 0; m < 4; ++m) { const size_t ro = (size_t)(row0 + ai * 128 + m * 16) * ldc + col0;
#pragma unroll
                for (int bj = 0; bj < 2; ++bj)
#pragma unroll
                    for (int n = 0; n < 2; ++n) { const f32x4 b = *(const f32x4*)(base + ro + bj * 128 + n * 16); { const f32x4 o_ = acc[ai][bj][m][n] + b; NT_STORE(o_, (f32x4*)(out + ro + bj * 128 + n * 16)); } } }
    }
};
struct SchedG2 {
    static constexpr int ldb = D * 2;
    pg8::TileOrder T; const char* A; const char* W;
    __device__ bool next(int i, pg8::GU& u) const { int pm, pn; if (!T.tile(i, pm, pn)) return false;
        u.a = A + (size_t)pm * 256 * D * 2; u.b0 = W + (size_t)pn * 256 * 2; u.b1 = u.b0 + 256; u.r0 = pm * 256; u.c0 = pn * 256; u.ex = 0; u.half = 0; return true; }
    __device__ int row(const pg8::GU&, int) const { return 0; }
};
struct EpiResid0 {
    static constexpr bool PERM = false;
    const float* x; const float* meta; float* out;
    __device__ __forceinline__ void operator()(const f32x4 (&acc)[2][2][4][2], const pg8::GU& u, int wr, int wc, int fr, int fq) const {
        const int row0 = u.r0 + wr * 64 + fr, col0 = u.c0 + wc * 32 + 4 * fq;
#pragma unroll
        for (int ai = 0; ai < 2; ++ai) if (ai == 0 || !u.half)
#pragma unroll
            for (int m = 0; m < 4; ++m) { const int r = row0 + ai * 128 + m * 16, b = r / PB, pp = r % PB, l = pp - LEADP;
                const float* src = l < 0 ? nullptr : (l < NMETA ? meta + (size_t)l * D : x + ((size_t)b * SEQ + (l - NMETA)) * D);
                const size_t ro = (size_t)r * D + col0;
#pragma unroll
                for (int bj = 0; bj < 2; ++bj)
#pragma unroll
                    for (int n = 0; n < 2; ++n) { f32x4 bsv = (f32x4){0.f, 0.f, 0.f, 0.f}; if (src) bsv = *(const f32x4*)(src + col0 + bj * 128 + n * 16);
                        *(f32x4*)(out + ro + bj * 128 + n * 16) = acc[ai][bj][m][n] + bsv; } }
    }
};
__device__ __forceinline__ void phase_g2(const Params& p, int layer, LAS unsigned char* lds) {
    SchedG2 S; S.T.init(R / 256, D / 256, gridDim.x, blockIdx.x); S.A = (const char*)(p.ws + WS_MIXED); S.W = (const char*)(p.ws + WS_WTOUT) + (size_t)layer * D * D * 2;
    if (layer == 0) { EpiResid0 E{p.x, p.meta, (float*)(p.ws + WS_H1)}; pg8::gemm_phase<EpiResid0, SchedG2, false, 1>(lds, D, S, E); }
    else { EpiResid E{(const float*)(p.ws + WS_H0), (float*)(p.ws + WS_H1), D}; pg8::gemm_phase<EpiResid, SchedG2, false, 1>(lds, D, S, E); }
}
constexpr int RTOK = NB * LTOK;
constexpr int RPADMAX = 2 * RTOK + NE * 255;
constexpr size_t WS_W1T  = WS_MIX_END;
constexpr size_t WS_W3T  = WS_W1T + al256((size_t)DEPTH * NE * DE * D * 2);
constexpr size_t WS_W2T  = WS_W3T + al256((size_t)DEPTH * NE * DE * D * 2);
constexpr size_t WS_LIST = WS_W2T + al256((size_t)DEPTH * NE * D * DE * 2);
constexpr size_t WS_ROUTE = WS_LIST + al256((size_t)NE * RTOK * 4);
constexpr size_t WS_END  = WS_ROUTE + al256((size_t)R * 32);
constexpr size_t WS_HB = WS_MIXED;
constexpr size_t WS_YB = WS_PROJ;
static_assert((size_t)RPADMAX * DE * 2 <= WS_W1T - WS_MIXED, "H overlay");
static_assert((size_t)RPADMAX * D * 2 <= WS_GATES - WS_PROJ, "Y overlay");
#ifndef MOE_FP32
#define MOE_FP32 0
#endif
constexpr int MOE_TILE = MOE_FP32 ? 128 : 256;
constexpr int LDS_TAB = 131072;
struct Route { int e[2]; float w[2]; int slot[2]; int pad[2]; };

constexpr int CNT_STRIDE = 64;
__device__ __forceinline__ int* moe_cnt(const Params& p, int layer) { return (int*)(p.ws + WS_CTL) + CW_CNT + layer * 32 * CNT_STRIDE; }

__device__ __forceinline__ void phase_n2(const Params& p, int layer, LAS unsigned char* lds) {
    const int tid = opaque_tid(), lane = tid & 63, wave = __builtin_amdgcn_readfirstlane(tid >> 6), fr = lane & 15, fq = lane >> 4;
    static_assert(RTOK % 16 == 0, "16-token tiles");
    constexpr int NT = RTOK / 16;
    const float* h1 = (const float*)(p.ws + WS_H1); bf16_t* U = (bf16_t*)(p.ws + WS_U);
    const bf16_t* wrf = (const bf16_t*)(p.ws + WS_WRT) + (size_t)layer * WRF_LAYER + (size_t)lane * 8;
    const int half = wave >> 2, kq = wave & 3;
    LAS float* PART = (LAS float*)lds;
    LAS float* LG = (LAS float*)(lds + 32768) + half * (16 * 48 + 16);
#pragma unroll 1
    for (int pass = 0; pass * 2 * (int)gridDim.x < NT; ++pass) {
        const int tile = (int)blockIdx.x + (int)gridDim.x * (2 * pass + half);
        const bool act = tile < NT;
        const int tl = act ? tile : 0;
        const int t = tl * 16 + fr, rowA = (t / LTOK) * PB + LEADP + (t % LTOK);
        const float* ap = h1 + (size_t)rowA * D + kq * 512 + 8 * fq;
        f32x4 acc[3];
#pragma unroll
        for (int ct = 0; ct < 3; ++ct) acc[ct] = (f32x4){0.f, 0.f, 0.f, 0.f};
        float ss = 0.f;
        if (act) {
#pragma unroll 4
            for (int k = 0; k < 16; ++k) {
                const int ks = kq * 16 + k;
                const f32x4 c0 = *(const f32x4*)(ap + k * 32), c1 = *(const f32x4*)(ap + k * 32 + 4);
                bf16x8 bh[3], bl[3];
#pragma unroll
                for (int ct = 0; ct < 3; ++ct) { bh[ct] = *(const bf16x8*)(wrf + ((size_t)(ks * 3 + ct) * 2) * 512); bl[ct] = *(const bf16x8*)(wrf + ((size_t)(ks * 3 + ct) * 2 + 1) * 512); }
                const float xv[8] = {c0.x, c0.y, c0.z, c0.w, c1.x, c1.y, c1.z, c1.w};
                float hi[8], lo[8];
#pragma unroll
                for (int j = 0; j < 8; ++j) { ss += xv[j] * xv[j]; hi[j] = bf2f(f2bf(xv[j])); lo[j] = xv[j] - hi[j]; }
                const u32x4 ph = pack8(hi), pl = pack8(lo);
                const bf16x8 ah = __builtin_bit_cast(bf16x8, ph), al = __builtin_bit_cast(bf16x8, pl);
#pragma unroll
                for (int ct = 0; ct < 3; ++ct) { acc[ct] = mfma16(ah, bh[ct], acc[ct]); acc[ct] = mfma16(ah, bl[ct], acc[ct]); acc[ct] = mfma16(al, bh[ct], acc[ct]); }
            }
        }
#pragma unroll
        for (int ct = 0; ct < 3; ++ct)
#pragma unroll
            for (int r = 0; r < 4; ++r) PART[(wave * 13 + ct * 4 + r) * 64 + lane] = acc[ct][r];
        PART[(wave * 13 + 12) * 64 + lane] = ss;
        __syncthreads();
        if (kq == 0) {
            float tot[13];
#pragma unroll
            for (int i = 0; i < 13; ++i) tot[i] = PART[((wave + 0) * 13 + i) * 64 + lane] + PART[((wave + 1) * 13 + i) * 64 + lane] + PART[((wave + 2) * 13 + i) * 64 + lane] + PART[((wave + 3) * 13 + i) * 64 + lane];
            float sq = tot[12]; sq += __shfl_xor(sq, 16); sq += __shfl_xor(sq, 32);
            const float rs = rsqrtf(sq * (1.f / D) + EPS);
#pragma unroll
            for (int ct = 0; ct < 3; ++ct)
#pragma unroll
                for (int r = 0; r < 4; ++r) LG[(4 * fq + r) * 48 + ct * 16 + fr] = tot[ct * 4 + r];
            if (fq == 0) LG[16 * 48 + fr] = rs;
            LDS_WAIT(); asm volatile("" ::: "memory");
            if (act && lane < 16) {
                const LAS float* lg = LG + lane * 48;
                float l[4];
#pragma unroll
                for (int g = 0; g < 4; ++g) l[g] = lg[g] * rs + p.bg[layer * 4 + g];
                int gs = 0; float gm = l[0];
#pragma unroll
                for (int g = 1; g < 4; ++g) if (l[g] > gm) { gm = l[g]; gs = g; }
                float den = 0.f;
#pragma unroll
                for (int g = 0; g < 4; ++g) den += __expf(l[g] - gm);
                const float ggate = 1.f / den;
                float v0 = -3.0e38f, v1 = -3.0e38f; int i0 = 0, i1 = 0;
#pragma unroll
                for (int e = 0; e < 8; ++e) { const float x = lg[4 + gs * 8 + e] * rs + p.br[layer * 32 + gs * 8 + e];
                    if (x > v0) { v1 = v0; i1 = i0; v0 = x; i0 = e; } else if (x > v1) { v1 = x; i1 = e; } }
                int* cnt = moe_cnt(p, layer); int* list = (int*)(p.ws + WS_LIST); Route* route = (Route*)(p.ws + WS_ROUTE);
                const float p1 = __expf(v1 - v0), sden = 1.f + p1;
                Route rt; rt.e[0] = gs * 8 + i0; rt.e[1] = gs * 8 + i1; rt.w[0] = ggate / sden; rt.w[1] = ggate * p1 / sden;
                rt.slot[0] = atomicAdd(&cnt[rt.e[0] * CNT_STRIDE], 1); rt.slot[1] = atomicAdd(&cnt[rt.e[1] * CNT_STRIDE], 1); rt.pad[0] = 0; rt.pad[1] = 0;
                list[rt.e[0] * RTOK + rt.slot[0]] = rowA; list[rt.e[1] * RTOK + rt.slot[1]] = rowA;
                route[rowA] = rt;
            }
        }
        __syncthreads();
        if (act) {
            const float* wn = p.nfw + (size_t)layer * D;
#pragma unroll 2
            for (int q = 0; q < 4; ++q) {
                const int rr = kq * 4 + q, tq = tl * 16 + rr, rq = (tq / LTOK) * PB + LEADP + (tq % LTOK);
                const float rsq = LG[16 * 48 + rr];
#pragma unroll
                for (int j = 0; j < 8; ++j) { const f32x4 u = *(const f32x4*)(h1 + (size_t)rq * D + 4 * lane + 256 * j) * rsq * *(const f32x4*)(wn + 4 * lane + 256 * j);
                    u32x2 o; o.x = cvt_pk_bf16(u.x, u.y); o.y = cvt_pk_bf16(u.z, u.w); *(u32x2*)(U + (size_t)rq * D + 4 * lane + 256 * j) = o; }
            }
        }
        __syncthreads();
    }
}

__device__ __forceinline__ void moe_tables(const Params& p, int layer, LAS unsigned char* lds) {
    LAS int* tab = (LAS int*)(lds + LDS_TAB);
    if (opaque_tid() == 0) { const int* cnt = moe_cnt(p, layer); int acc = 0;
        for (int e = 0; e < NE; ++e) { const int c = cnt[e * CNT_STRIDE]; tab[e] = c; tab[32 + e] = acc; acc += (c + MOE_TILE - 1) / MOE_TILE; }
        tab[64] = acc; }
    __syncthreads();
}
__device__ __forceinline__ int moe_find(LAS const int* tab, int ti) { int e = 0;
#pragma unroll 1
    for (int k = 1; k < NE; ++k) if (tab[32 + k] <= ti) e = k;
    return e; }

#ifndef MOE_XCD
#define MOE_XCD 1
#endif
#define MOE_VCU ((MOE_XCD && (gridDim.x % 8 == 0)) ? (int)((blockIdx.x % 8) * (gridDim.x / 8) + blockIdx.x / 8) : (int)blockIdx.x)
struct SchedMoe1 {
    static constexpr int ldb = DE * 2;
    LAS const int* tab; const int* list; const char* U; const char* W1; const char* W3; int G, c;
    __device__ bool next(int i, pg8::GU& u) const {
        const int Lx = i * G + c; if (Lx >= tab[64] * 4) return false;
        const int ct = Lx & 3, ti = Lx >> 2, e = moe_find(tab, ti), rt = ti - tab[32 + e];
        u.a = U; const size_t wo = ((size_t)e * D * DE + ct * 128) * 2; u.b0 = W1 + wo; u.b1 = W3 + wo; u.r0 = ti * 256; u.c0 = ct * 128; u.ex = e | (rt << 8); u.half = (tab[e] - rt * 256) <= 128; return true; }
    __device__ int row(const pg8::GU& u, int r) const { const int e = u.ex & 255, rt = u.ex >> 8, c_ = tab[e]; int idx = rt * 256 + r; idx = idx < c_ ? idx : c_ - 1; return list[e * RTOK + idx]; }
};
struct EpiSwiglu {
    static constexpr bool PERM = false;
    bf16_t* H;
    __device__ __forceinline__ void operator()(const f32x4 (&acc)[2][2][4][2], const pg8::GU& u, int wr, int wc, int fr, int fq) const {
        const int row0 = u.r0 + wr * 64 + fr, col0 = u.c0 + wc * 32 + 4 * fq;
#pragma unroll
        for (int ai = 0; ai < 2; ++ai)
#pragma unroll
            for (int m = 0; m < 4; ++m) { bf16_t* rowp = H + (size_t)(row0 + ai * 128 + m * 16) * DE + col0;
#pragma unroll
                for (int n = 0; n < 2; ++n) { float h[4];
#pragma unroll
                    for (int k = 0; k < 4; ++k) h[k] = siluf_(acc[ai][0][m][n][k]) * acc[ai][1][m][n][k];
                    u32x2 o; o.x = cvt_pk_bf16(h[0], h[1]); o.y = cvt_pk_bf16(h[2], h[3]); NT_STORE(o, (u32x2*)(rowp + n * 16)); } }
    }
};
struct EpiBf16Store2 {
    static constexpr bool PERM = false;
    bf16_t* O; int ldc;
    __device__ __forceinline__ void operator()(const f32x4 (&acc)[2][2][4][2], const pg8::GU& u, int wr, int wc, int fr, int fq) const {
        const int row0 = u.r0 + wr * 64 + fr, col0 = u.c0 + wc * 32 + 4 * fq;
#pragma unroll
        for (int ai = 0; ai < 2; ++ai)
#pragma unroll
            for (int m = 0; m < 4; ++m) { bf16_t* rowp = O + (size_t)(row0 + ai * 128 + m * 16) * ldc + col0;
#pragma unroll
                for (int bj = 0; bj < 2; ++bj)
#pragma unroll
                    for (int n = 0; n < 2; ++n) { const f32x4 v = acc[ai][bj][m][n]; u32x2 o; o.x = cvt_pk_bf16(v[0], v[1]); o.y = cvt_pk_bf16(v[2], v[3]); NT_STORE(o, (u32x2*)(rowp + bj * 128 + n * 16)); } }
    }
};
__device__ __forceinline__ void phase_e1(const Params& p, int layer, LAS unsigned char* lds) {
    moe_tables(p, layer, lds);
    SchedMoe1 S; S.tab = (LAS const int*)(lds + LDS_TAB); S.list = (const int*)(p.ws + WS_LIST); S.U = (const char*)(p.ws + WS_U);
    S.W1 = (const char*)(p.ws + WS_W1T) + (size_t)layer * NE * DE * D * 2; S.W3 = (const char*)(p.ws + WS_W3T) + (size_t)layer * NE * DE * D * 2; S.G = gridDim.x; S.c = MOE_VCU;
    EpiSwiglu E{(bf16_t*)(p.ws + WS_HB)};
    pg8::gemm_phase<EpiSwiglu, SchedMoe1, true, 1>(lds, D, S, E);
}
struct SchedMoe2 {
    static constexpr int ldb = D * 2;
    LAS const int* tab; const char* H; const char* W2; int G, c;
    __device__ bool next(int i, pg8::GU& u) const {
        const int Lx = i * G + c; if (Lx >= tab[64] * 8) return false;
        const int ct = Lx & 7, ti = Lx >> 3, e = moe_find(tab, ti);
        u.a = H + (size_t)ti * 256 * DE * 2; u.b0 = W2 + ((size_t)e * DE * D + ct * 256) * 2; u.b1 = u.b0 + 256; u.r0 = ti * 256; u.c0 = ct * 256; u.ex = e; u.half = (tab[e] - (ti - tab[32 + e]) * 256) <= 128; return true; }
    __device__ int row(const pg8::GU&, int) const { return 0; }
};
__device__ __forceinline__ void phase_e2(const Params& p, int layer, LAS unsigned char* lds) {
    moe_tables(p, layer, lds);
    SchedMoe2 S; S.tab = (LAS const int*)(lds + LDS_TAB); S.H = (const char*)(p.ws + WS_HB); S.W2 = (const char*)(p.ws + WS_W2T) + (size_t)layer * NE * D * DE * 2; S.G = gridDim.x; S.c = MOE_VCU;
    EpiBf16Store2 E{(bf16_t*)(p.ws + WS_YB), D};
    pg8::gemm_phase<EpiBf16Store2, SchedMoe2, false, 1>(lds, DE, S, E);
}

__device__ __forceinline__ int combine_excl(const Params& p, int layer, int lane) {
    const int* cnt = moe_cnt(p, layer);
    int nt = 0; if (lane < NE) nt = (cnt[lane * CNT_STRIDE] + MOE_TILE - 1) / MOE_TILE;
    int incl = nt;
#pragma unroll
    for (int o = 1; o < 32; o <<= 1) { const int t = __shfl_up(incl, o); if (lane >= o) incl += t; }
    return incl - nt;
}
__device__ __forceinline__ void load_combined(const Params& p, int excl, int r, int lane, f32x4 (&v)[8]) {
    const Route q = ((const Route*)(p.ws + WS_ROUTE))[r];
    const size_t r0 = (size_t)(__shfl(excl, q.e[0]) * MOE_TILE + q.slot[0]) * D, r1 = (size_t)(__shfl(excl, q.e[1]) * MOE_TILE + q.slot[1]) * D;
    const float* h1 = (const float*)(p.ws + WS_H1) + (size_t)r * D; const bf16_t* Y = (const bf16_t*)(p.ws + WS_YB);
#pragma unroll
    for (int j = 0; j < 8; ++j) {
        const f32x4 h = N1_LD((const f32x4*)(h1 + 4 * lane + 256 * j));
        const u32x2 a = N1_LD((const u32x2*)(Y + r0 + 4 * lane + 256 * j)), bq = N1_LD((const u32x2*)(Y + r1 + 4 * lane + 256 * j));
        v[j].x = h.x + q.w[0] * bflo(a.x) + q.w[1] * bflo(bq.x); v[j].y = h.y + q.w[0] * bfhi(a.x) + q.w[1] * bfhi(bq.x);
        v[j].z = h.z + q.w[0] * bflo(a.y) + q.w[1] * bflo(bq.y); v[j].w = h.w + q.w[0] * bfhi(a.y) + q.w[1] * bfhi(bq.y);
    }
}
template <>
__device__ __forceinline__ void n1_load_row<2>(const Params& p, const N1Src& sr, int excl, int r, int lane, f32x4 (&v)[8]) {
    const int pp = r % PB;
    if (pp < LEADP) {
#pragma unroll
        for (int j = 0; j < 8; ++j) v[j] = (f32x4){0.f, 0.f, 0.f, 0.f};
    } else { (void)sr; load_combined(p, excl, r, lane, v); }
}
__device__ __forceinline__ void phase_fn(const Params& p) {
    const int tid = opaque_tid(), lane = tid & 63, wave = __builtin_amdgcn_readfirstlane(tid >> 6);
    const int gw = blockIdx.x * NWAVES + wave, NGW = gridDim.x * NWAVES;
    f32x4 wv[8];
#pragma unroll
    for (int j = 0; j < 8; ++j) wv[j] = *(const f32x4*)(p.fnw + 4 * lane + 256 * j);
    const int excl = combine_excl(p, DEPTH - 1, lane);
    for (int task = gw; task < NB * SEQ; task += NGW) {
        const int b = task / SEQ, s = task % SEQ, r = b * PB + 64 + s;
        f32x4 v[8]; load_combined(p, excl, r, lane, v);
        float ss = 0.f;
#pragma unroll
        for (int j = 0; j < 8; ++j) ss += (v[j].x * v[j].x + v[j].y * v[j].y) + (v[j].z * v[j].z + v[j].w * v[j].w);
        const float rs = rsqrtf(wave_sum(ss) * (1.f / D) + EPS);
#pragma unroll
        for (int j = 0; j < 8; ++j) { const f32x4 o_ = v[j] * rs * wv[j]; __builtin_nontemporal_store(o_, (f32x4*)(p.out + (size_t)task * D + 4 * lane + 256 * j)); }
    }
}
constexpr int CW_QHEAD = 8192;
constexpr int QPER = NE * D * DE / 4096;
constexpr int QITEMS = 3 * QPER;
static_assert(WS_W3T - WS_W1T == WS_W2T - WS_W3T, "the three bf16 expert-weight copies are equally spaced");
__device__ __forceinline__ void convert_items(LAS unsigned char* lds, int layer, int first, int n) {
    const int tid = opaque_tid();
    unsigned char* ws = (unsigned char*)lds_ptr(lds, 26);
    for (int it = first; it < first + n; ++it) {
        const int w = it / QPER, off = it % QPER;
        const size_t e0 = (((size_t)layer * QPER + off) * 512 + tid) * 8;
        const float* src = (const float*)lds_ptr(lds, 21 + w) + e0;
        bf16_t* dst = (bf16_t*)(ws + WS_W1T + (size_t)w * (WS_W3T - WS_W1T)) + e0;
        const f32x4 a = __builtin_nontemporal_load((const f32x4*)src), b = __builtin_nontemporal_load((const f32x4*)(src + 4));
        u32x4 o; o.x = cvt_pk_bf16(a.x, a.y); o.y = cvt_pk_bf16(a.z, a.w); o.z = cvt_pk_bf16(b.x, b.y); o.w = cvt_pk_bf16(b.z, b.w);
        __builtin_nontemporal_store(o, (u32x4*)dst);
    }
}
constexpr int CW_DONE = 8192 + 256;
__device__ __forceinline__ void convert_until(const Params& p, LAS unsigned char* lds, int lfirst, int llast, int phase_id, int my_units, int total_units) {
    LAS int* slot = (LAS int*)(lds + LDS_QSLOT);
    unsigned* donew = (unsigned*)(p.ws + WS_CTL) + CW_DONE + 64 * phase_id;
    if (threadIdx.x == 0 && my_units > 0) (void)__hip_atomic_fetch_add(donew, (unsigned)my_units, __ATOMIC_RELAXED, __HIP_MEMORY_SCOPE_AGENT);
    int layer = lfirst;
    for (int it = 0; it < 8192; ++it) {
        if (layer > llast || layer >= DEPTH) break;
        if (threadIdx.x == 0) {
            const unsigned dn = __hip_atomic_load(donew, __ATOMIC_RELAXED, __HIP_MEMORY_SCOPE_AGENT);
            int v = -1;
            if (dn < (unsigned)total_units) v = (int)__hip_atomic_fetch_add((unsigned*)(p.ws + WS_CTL) + CW_QHEAD + 64 * layer, 2u, __ATOMIC_RELAXED, __HIP_MEMORY_SCOPE_AGENT);
            *slot = v; }
        __syncthreads();
        const int base = __builtin_amdgcn_readfirstlane(*slot);
        __syncthreads();
        if (base < 0) break;
        if (base >= QITEMS) { ++layer; continue; }
        convert_items(lds, layer, base, 2 < QITEMS - base ? 2 : QITEMS - base);
    }
}
__device__ __forceinline__ void convert_bg(const Params& p, LAS unsigned char* lds, int lfirst, int llast, int budget) {
    LAS int* slot = (LAS int*)(lds + LDS_QSLOT);
    for (int layer = lfirst; layer <= llast && layer < DEPTH; ++layer) {
        unsigned* qh = (unsigned*)(p.ws + WS_CTL) + CW_QHEAD + 64 * layer;
        while (budget > 0) {
            const int n = budget < 8 ? budget : 8;
            if (threadIdx.x == 0) *slot = (int)__hip_atomic_fetch_add(qh, (unsigned)n, __ATOMIC_RELAXED, __HIP_MEMORY_SCOPE_AGENT);
            __syncthreads();
            const int base = __builtin_amdgcn_readfirstlane(*slot);
            __syncthreads();
            if (base >= QITEMS) break;
            convert_items(lds, layer, base, n < QITEMS - base ? n : QITEMS - base);
            budget -= n;
        }
    }
}
#ifndef RPT_P0
#define RPT_P0 1
#endif
#ifndef RPT_N1
#define RPT_N1 1
#endif
#ifndef RPT_G1
#define RPT_G1 1
#endif
#ifndef RPT_MA
#define RPT_MA 1
#endif
#ifndef RPT_MC
#define RPT_MC 1
#endif
#ifndef RPT_G2
#define RPT_G2 1
#endif
#ifndef RPT_E1
#define RPT_E1 1
#endif
#ifndef RPT_E2
#define RPT_E2 1
#endif
#ifndef RPT_FN
#define RPT_FN 1
#endif
#ifndef RPT_N2
#define RPT_N2 1
#endif
#ifndef RPT_MAB
#define RPT_MAB 1
#endif
#ifndef RPT_BAR
#define RPT_BAR 1
#endif

__device__ __forceinline__ Params load_params(LAS unsigned char* lds) {
    asm volatile("" ::: "memory");
    Params p;
    p.x = (const float*)lds_ptr(lds, 0); p.meta = (const float*)lds_ptr(lds, 1); p.lbl = (const float*)lds_ptr(lds, 2); p.nmw = (const float*)lds_ptr(lds, 3); p.w_in = (const float*)lds_ptr(lds, 4);
    p.hgnw = (const float*)lds_ptr(lds, 5); p.mbi = (const float*)lds_ptr(lds, 6); p.mbf = (const float*)lds_ptr(lds, 7); p.mlnw = (const float*)lds_ptr(lds, 8); p.cw = (const float*)lds_ptr(lds, 9);
    p.cb = (const float*)lds_ptr(lds, 10); p.dtb = (const float*)lds_ptr(lds, 11); p.alog = (const float*)lds_ptr(lds, 12); p.dsk = (const float*)lds_ptr(lds, 13); p.ssnw = (const float*)lds_ptr(lds, 14);
    p.w_out = (const float*)lds_ptr(lds, 15); p.nfw = (const float*)lds_ptr(lds, 16); p.wg = (const float*)lds_ptr(lds, 17); p.bg = (const float*)lds_ptr(lds, 18); p.wr = (const float*)lds_ptr(lds, 19);
    p.br = (const float*)lds_ptr(lds, 20); p.w1 = (const float*)lds_ptr(lds, 21); p.w3 = (const float*)lds_ptr(lds, 22); p.w2 = (const float*)lds_ptr(lds, 23); p.fnw = (const float*)lds_ptr(lds, 24);
    p.out = (float*)lds_ptr(lds, 25); p.ws = (unsigned char*)lds_ptr(lds, 26);
    return p;
}
__device__ __forceinline__ void grid_bar(LAS unsigned char* lds) {
    asm volatile("" ::: "memory");
    XcdBarrier b; b.bar = (unsigned*)((unsigned char*)lds_ptr(lds, 26) + WS_CTL) + CW_BAR;
    b.x = (unsigned)__builtin_amdgcn_readfirstlane((int)*(const LAS unsigned*)(lds + LDS_PARAMS + 8 * 27)); b.st = (volatile LAS unsigned*)(lds + LDS_BARW);
    xcd_barrier(b);
}
#if MOE_FP32
#define convert_bg(...) ((void)0)
#define MOE_E1 phase_e1x
#define MOE_E2 phase_e2x
#else
#define MOE_E1 phase_e1
#define MOE_E2 phase_e2
#endif
__global__ void __launch_bounds__(NTHREADS, 2) k_mega(Params pk) {
    extern __shared__ __attribute__((aligned(16))) unsigned char lds_raw[];
    LAS unsigned char* lds = (LAS unsigned char*)lds_raw;
    if (threadIdx.x == 0) {
        *(LAS u32x4*)(lds + LDS_BARW) = (u32x4){0u, 0u, 0u, 0u};
        LAS unsigned long long* q = (LAS unsigned long long*)(lds + LDS_PARAMS);
        q[0] = (unsigned long long)pk.x; q[1] = (unsigned long long)pk.meta; q[2] = (unsigned long long)pk.lbl; q[3] = (unsigned long long)pk.nmw; q[4] = (unsigned long long)pk.w_in;
        q[5] = (unsigned long long)pk.hgnw; q[6] = (unsigned long long)pk.mbi; q[7] = (unsigned long long)pk.mbf; q[8] = (unsigned long long)pk.mlnw; q[9] = (unsigned long long)pk.cw;
        q[10] = (unsigned long long)pk.cb; q[11] = (unsigned long long)pk.dtb; q[12] = (unsigned long long)pk.alog; q[13] = (unsigned long long)pk.dsk; q[14] = (unsigned long long)pk.ssnw;
        q[15] = (unsigned long long)pk.w_out; q[16] = (unsigned long long)pk.nfw; q[17] = (unsigned long long)pk.wg; q[18] = (unsigned long long)pk.bg; q[19] = (unsigned long long)pk.wr;
        q[20] = (unsigned long long)pk.br; q[21] = (unsigned long long)pk.w1; q[22] = (unsigned long long)pk.w3; q[23] = (unsigned long long)pk.w2; q[24] = (unsigned long long)pk.fnw;
        q[25] = (unsigned long long)pk.out; q[26] = (unsigned long long)pk.ws;
    }
    __syncthreads();
    { const XcdBarrier b0 = xcd_barrier_post((unsigned*)(pk.ws + WS_CTL) + CW_BAR, (volatile LAS unsigned*)(lds + LDS_BARW));
      if (threadIdx.x == 0) *(LAS unsigned*)(lds + LDS_PARAMS + 8 * 27) = b0.x; }
    __syncthreads();
#define PH(stmt) do { { const Params p = load_params(lds); stmt; } for (int _b = 0; _b < RPT_BAR; ++_b) grid_bar(lds); } while (0)
#define PHR(n, stmt) do { for (int _r = 0; _r < (n); ++_r) PH(stmt); } while (0)
    for (int _r = 0; _r < RPT_P0; ++_r) { const Params p = load_params(lds); phase_p0(p, lds); }
#ifndef BG_G1
#define BG_G1 40
#endif
#ifndef BG_MA
#define BG_MA 8
#endif
#ifndef BG_MC
#define BG_MC 15
#endif
#ifndef BG_G2
#define BG_G2 45
#endif
#ifndef BG_E1
#define BG_E1 45
#endif
#ifndef BG_E2
#define BG_E2 14
#endif
    const int bx = blockIdx.x, G_ = gridDim.x;
#define MY_UNITS(total) ((bx < (total)) ? (((total) - bx + G_ - 1) / G_) : 0)
#define IDLE_UNITS(total) ((((total) + G_ - 1) / G_) - ((bx < (total)) ? (((total) - bx + G_ - 1) / G_) : 0))
#define IDLE_UNITS_C(total, cc) ((((total) + G_ - 1) / G_) - (((cc) < (total)) ? (((total) - (cc) + G_ - 1) / G_) : 0))
#ifndef DYN_FILL
#define DYN_FILL 0
#endif
#define MY_UNITS_C(total, cc) (((cc) < (total)) ? (((total) - (cc) + G_ - 1) / G_) : 0)
#define LAYER(layer) do { N1Src src{}; src.layer_prev = (layer) - 1; \
        PHR(RPT_N1, if ((layer) == 0) phase_n1<0>(p, (layer), src); else phase_n1<2>(p, (layer), src)); \
        PHR(RPT_G1, phase_g1(p, (layer), lds); if (DYN_FILL) convert_until(p, lds, (layer), DEPTH - 1, (layer) * 8 + 0, MY_UNITS_C((R / 256) * (NPROJX / 256), bx), (R / 256) * (NPROJX / 256)); else convert_bg(p, lds, (layer), DEPTH - 1, BG_G1 * IDLE_UNITS((R / 256) * (NPROJX / 256)))); \
        PHR(RPT_MA, phase_mix<false>(p, (layer), lds); convert_bg(p, lds, (layer), DEPTH - 1, BG_MA * IDLE_UNITS(3 * NCH * 4))); \
        PH(phase_scan(p)); \
        for (int _n = 1; _n < RPT_MAB; ++_n) { PH(phase_mix<false>(p, (layer), lds)); PH(phase_scan(p)); } \
        PHR(RPT_MC, phase_mix<true>(p, (layer), lds); convert_bg(p, lds, (layer), DEPTH - 1, BG_MC * IDLE_UNITS(3 * NCH * 4))); \
        PHR(RPT_G2, phase_g2(p, (layer), lds); if (DYN_FILL) convert_until(p, lds, (layer), DEPTH - 1, (layer) * 8 + 3, MY_UNITS_C((R / 256) * (D / 256), bx), (R / 256) * (D / 256)); else convert_bg(p, lds, (layer), DEPTH - 1, BG_G2 * IDLE_UNITS((R / 256) * (D / 256)))); \
        for (int _n = 1; _n < RPT_N2; ++_n) { PH(phase_n2(p, (layer), lds)); PH(if (blockIdx.x == 0 && threadIdx.x < 32) moe_cnt(p, (layer))[threadIdx.x * CNT_STRIDE] = 0); } \
        PH(phase_n2(p, (layer), lds); convert_bg(p, lds, (layer), (layer), QITEMS)); \
        PHR(RPT_E1, MOE_E1(p, (layer), lds); { const int T_ = 4 * *(const LAS int*)(lds + LDS_TAB + 256); if (DYN_FILL) convert_until(p, lds, (layer) + 1, DEPTH - 1, (layer) * 8 + 4, MY_UNITS_C(T_, MOE_VCU), T_); else convert_bg(p, lds, (layer) + 1, DEPTH - 1, BG_E1 * IDLE_UNITS_C(T_, MOE_VCU)); }); \
        PHR(RPT_E2, MOE_E2(p, (layer), lds); { const int T_ = 8 * *(const LAS int*)(lds + LDS_TAB + 256); if (DYN_FILL) convert_until(p, lds, (layer) + 1, DEPTH - 1, (layer) * 8 + 5, MY_UNITS_C(T_, MOE_VCU), T_); else convert_bg(p, lds, (layer) + 1, DEPTH - 1, BG_E2 * IDLE_UNITS_C(T_, MOE_VCU)); }); } while (0)
    static_assert(DEPTH == 2, "two layers written out");
    LAYER(0);
    LAYER(1);
#undef LAYER
    for (int _r = 0; _r < RPT_FN; ++_r) { const Params p = load_params(lds); phase_fn(p); }
#undef PH
}

extern "C" void kernel_launch(void* const* d_in, const int* in_sizes, int n_in, void* d_out, int out_size, void* d_ws, size_t ws_size, hipStream_t stream) {
    Params p{};
    p.x = (const float*)d_in[0]; p.meta = (const float*)d_in[1]; p.lbl = (const float*)d_in[2]; p.nmw = (const float*)d_in[3]; p.w_in = (const float*)d_in[4];
    p.hgnw = (const float*)d_in[5]; p.mbi = (const float*)d_in[6]; p.mbf = (const float*)d_in[7]; p.mlnw = (const float*)d_in[8]; p.cw = (const float*)d_in[9];
    p.cb = (const float*)d_in[10]; p.dtb = (const float*)d_in[11]; p.alog = (const float*)d_in[12]; p.dsk = (const float*)d_in[13]; p.ssnw = (const float*)d_in[14];
    p.w_out = (const float*)d_in[15]; p.nfw = (const float*)d_in[16]; p.wg = (const float*)d_in[17]; p.bg = (const float*)d_in[18]; p.wr = (const float*)d_in[19];
    p.br = (const float*)d_in[20]; p.w1 = (const float*)d_in[21]; p.w3 = (const float*)d_in[22]; p.w2 = (const float*)d_in[23]; p.fnw = (const float*)d_in[24];
    p.out = (float*)d_out; p.ws = (unsigned char*)d_ws;
    static int grid = 0;
    if (grid == 0) {
        int dev = 0, cus = 0, per_cu = 0;
        (void)hipGetDevice(&dev); (void)hipDeviceGetAttribute(&cus, hipDeviceAttributeMultiprocessorCount, dev);
        (void)hipFuncSetAttribute((const void*)k_mega, hipFuncAttributeMaxDynamicSharedMemorySize, LDS_BYTES);
        (void)hipOccupancyMaxActiveBlocksPerMultiprocessor(&per_cu, (const void*)k_mega, NTHREADS, LDS_BYTES);
        (void)hipGetLastError();
        grid = (per_cu >= 1 && cus > 0) ? cus : -1;
        if (WS_END > ws_size) { fprintf(stderr, "workspace too small: need %zu have %zu\n", (size_t)WS_END, ws_size); grid = -1; }
    }
    (void)n_in; (void)in_sizes; (void)out_size;
    if (grid < 0) return;
    (void)hipMemsetAsync((char*)d_ws + WS_CTL, 0, CTL_BYTES, stream);
    hipLaunchKernelGGL(k_mega, dim3(grid), dim3(NTHREADS), LDS_BYTES, stream, p);
}
```

```cpp
#include <hip/hip_runtime.h>
#include <stdint.h>
#include <cstdio>

#define LAS __attribute__((address_space(3)))
#define GAS __attribute__((address_space(1)))
typedef unsigned short bf16_t;
typedef short bf16x8 __attribute__((ext_vector_type(8)));
typedef short bf16x4 __attribute__((ext_vector_type(4)));
typedef float f32x4 __attribute__((ext_vector_type(4)));
typedef float f32x2 __attribute__((ext_vector_type(2)));
typedef unsigned u32x4 __attribute__((ext_vector_type(4)));
typedef unsigned u32x2 __attribute__((ext_vector_type(2)));

constexpr int D = 2048, NB = 4, SEQ = 2048, NMETA = 16, LTOK = SEQ + NMETA, DEPTH = 2;
constexpr int PB = 2112;
constexpr int LEADP = 48;
constexpr int R = NB * PB;
constexpr int NCH = R / 64;
constexpr int CPB = 33;
constexpr int D_IN = 6680, NPROJ = 6656, NGATE = 24;
constexpr int P_HQ = 0, P_HF = 512, P_HI = 1024, P_HG = 1536, P_MQ = 2048, P_MK = 2304, P_MV = 2560, P_MO = 3072, P_SZ = 3584, P_SX = 4608, P_SB = 5632, P_SC = 6144;
constexpr int NE = 32, DE = 512;
constexpr float EPS = 1e-6f;
constexpr int NTHREADS = 512, NWAVES = 8;

typedef __bf16 bf16n2 __attribute__((ext_vector_type(2)));
__device__ __forceinline__ unsigned cvt_pk_bf16(float lo, float hi) { bf16n2 v; v[0] = (__bf16)lo; v[1] = (__bf16)hi; return __builtin_bit_cast(unsigned, v); }
__device__ __forceinline__ bf16_t f2bf(float f) { return (bf16_t)(cvt_pk_bf16(f, 0.f) & 0xffffu); }
__device__ __forceinline__ float bf2f(bf16_t b) { return __uint_as_float(((unsigned)b) << 16); }
__device__ __forceinline__ float bflo(unsigned w) { return __uint_as_float(w << 16); }
__device__ __forceinline__ float bfhi(unsigned w) { return __uint_as_float(w & 0xffff0000u); }
__device__ __forceinline__ void unpack8(const u32x4 w, float (&f)[8]) { f[0] = bflo(w.x); f[1] = bfhi(w.x); f[2] = bflo(w.y); f[3] = bfhi(w.y); f[4] = bflo(w.z); f[5] = bfhi(w.z); f[6] = bflo(w.w); f[7] = bfhi(w.w); }
__device__ __forceinline__ u32x4 pack8(const float (&f)[8]) { u32x4 w; w.x = cvt_pk_bf16(f[0], f[1]); w.y = cvt_pk_bf16(f[2], f[3]); w.z = cvt_pk_bf16(f[4], f[5]); w.w = cvt_pk_bf16(f[6], f[7]); return w; }
__device__ __forceinline__ int opaque_tid() { int t = threadIdx.x; asm volatile("" : "+v"(t)); return t; }
template <int CTRL, int ROWMASK> __device__ __forceinline__ float dpp_add_step(float v) {
    const int t = __builtin_amdgcn_update_dpp(0, __builtin_bit_cast(int, v), CTRL, ROWMASK, 0xF, false);
    return v + __builtin_bit_cast(float, t);
}
__device__ __forceinline__ float sum16_dpp(float v) {
    v = dpp_add_step<0xB1, 0xF>(v); v = dpp_add_step<0x4E, 0xF>(v); v = dpp_add_step<0x141, 0xF>(v); v = dpp_add_step<0x140, 0xF>(v);
    return v;
}
__device__ __forceinline__ float sum32_dpp(float v, int lane) {
    v = sum16_dpp(v);
    v = dpp_add_step<0x142, 0xA>(v);
    const float lo = __builtin_bit_cast(float, __builtin_amdgcn_readlane(__builtin_bit_cast(int, v), 31)), hi = __builtin_bit_cast(float, __builtin_amdgcn_readlane(__builtin_bit_cast(int, v), 63));
    return lane < 32 ? lo : hi;
}
__device__ __forceinline__ float wave_sum(float v) {
    v = dpp_add_step<0xB1, 0xF>(v);
    v = dpp_add_step<0x4E, 0xF>(v);
    v = dpp_add_step<0x141, 0xF>(v);
    v = dpp_add_step<0x140, 0xF>(v);
    v = dpp_add_step<0x142, 0xA>(v);
    v = dpp_add_step<0x143, 0xC>(v);
    return __builtin_bit_cast(float, __builtin_amdgcn_readlane(__builtin_bit_cast(int, v), 63));
}
__device__ __forceinline__ float sigmoidf_(float x) { return __builtin_amdgcn_rcpf(1.f + __expf(-x)); }
__device__ __forceinline__ float siluf_(float x) { return x * __builtin_amdgcn_rcpf(1.f + __expf(-x)); }
__device__ __forceinline__ float softplusf_(float x) { return x > 20.f ? x : log1pf(__expf(x)); }
__device__ __forceinline__ float logsigmoidf_(float x) { return fminf(x, 0.f) - log1pf(__expf(-fabsf(x))); }
#define LDS_WAIT() asm volatile("s_waitcnt lgkmcnt(0)" ::: "memory")
#define VM_WAIT() asm volatile("s_waitcnt vmcnt(0)" ::: "memory")

#define XB_TMO      128
#define XB_XCNT(j)  (256  + 64 * (j))
#define XB_XSUB(j)  (1280 + 64 * (j))
#define XB_XGEN(j)  (2304 + 64 * (j))
#define XB_TOP      3328
#define XB_TOPGEN   3392
#define XCD_BAR_WORDS 3456
#define XB_SPIN_CAP (1u << 18)
__device__ __forceinline__ unsigned xb_ld(unsigned* p)              { return __hip_atomic_load(p, __ATOMIC_RELAXED, __HIP_MEMORY_SCOPE_AGENT); }
__device__ __forceinline__ unsigned xb_add(unsigned* p, unsigned v) { return __hip_atomic_fetch_add(p, v, __ATOMIC_RELAXED, __HIP_MEMORY_SCOPE_AGENT); }
__device__ __forceinline__ unsigned xb_xcc_id() { return (unsigned)__builtin_amdgcn_s_getreg((3 << 11) | 20) & 0xFu; }
#define XB_SPIN(cond, bar) do { unsigned _sp = 0; while (cond) { __builtin_amdgcn_s_sleep(1); \
    if ((++_sp & 255u) == 0u) { if (xb_ld(&(bar)[XB_TMO])) break; if (_sp > XB_SPIN_CAP) { atomicAdd(&(bar)[XB_TMO], 1u); break; } } } } while (0)
struct XcdBarrier { unsigned* bar; unsigned x; volatile LAS unsigned* st; };
__device__ __forceinline__ XcdBarrier xcd_barrier_post(unsigned* bar, volatile LAS unsigned* st) {
    XcdBarrier b; b.bar = bar; b.x = xb_xcc_id(); b.st = st;
    if (threadIdx.x == 0) (void)xb_add(&bar[XB_XCNT(b.x)], 1u);
    return b;
}
__device__ __forceinline__ void xcd_barrier_complete(unsigned* bar, unsigned x, unsigned& nloc, unsigned& nx) {
    const unsigned G = gridDim.x * gridDim.y * gridDim.z;
    unsigned sum, cnt, mine, sp = 0u;
    for (;;) {
        sum = 0u; cnt = 0u; mine = 0u;
#pragma unroll
        for (unsigned j = 0; j < 16; ++j) { const unsigned c = xb_ld(&bar[XB_XCNT(j)]); sum += c; cnt += (c > 0u) ? 1u : 0u; mine = (j == x) ? c : mine; }
        if (sum == G) break;
        __builtin_amdgcn_s_sleep(1);
        if ((++sp & 255u) == 0u) { if (xb_ld(&bar[XB_TMO])) break; if (sp > XB_SPIN_CAP) { atomicAdd(&bar[XB_TMO], 1u); break; } }
    }
    nloc = mine > 0u ? mine : 1u; nx = cnt > 0u ? cnt : 1u;
}
__device__ __forceinline__ void xcd_barrier(const XcdBarrier& b) {
    asm volatile("s_waitcnt vmcnt(0)" ::: "memory");
    __syncthreads();
    if (threadIdx.x == 0) {
        unsigned* bar = b.bar;
        __builtin_amdgcn_s_waitcnt(0);
        unsigned nloc = b.st[0], nx = b.st[1];
        if (nloc == 0u) { xcd_barrier_complete(bar, b.x, nloc, nx); b.st[0] = nloc; b.st[1] = nx; }
        const unsigned old = xb_add(&bar[XB_XSUB(b.x)], 1u);
        const unsigned gen = old / nloc;
        if (old + 1u == (gen + 1u) * nloc) {
            __builtin_amdgcn_fence(__ATOMIC_RELEASE, "agent");
            asm volatile("s_waitcnt vmcnt(0)" ::: "memory");
            const unsigned og = xb_add(&bar[XB_TOP], 1u);
            const unsigned tg = og / nx;
            if (og + 1u == (tg + 1u) * nx) xb_add(&bar[XB_TOPGEN], 1u);
            else XB_SPIN(xb_ld(&bar[XB_TOPGEN]) == tg, bar);
            __builtin_amdgcn_fence(__ATOMIC_ACQUIRE, "agent");
            xb_add(&bar[XB_XGEN(b.x)], 1u);
            asm volatile("s_waitcnt vmcnt(0)" ::: "memory");
        } else {
            XB_SPIN(xb_ld(&bar[XB_XGEN(b.x)]) == gen, bar);
            __builtin_amdgcn_fence(__ATOMIC_ACQUIRE, "agent");
            asm volatile("s_waitcnt vmcnt(0)" ::: "memory");
        }
    }
    __syncthreads();
}
namespace pg8 {
#ifndef PG8_WGM
#define PG8_WGM 8
#endif
constexpr int BM = 256, BK = 64, HALF = 128, HTB = HALF * BK * 2, STAGE_BYTES = 8 * HTB, NXCD = 8, WGM = PG8_WGM;
__host__ __device__ __forceinline__ int lds_byte(int r, int c) { const int st = (r >> 4) * 2 + (c >> 5), rr = r & 15, cc = c & 31, ob = rr * 64 + cc * 2; return st * 1024 + (ob ^ (((ob >> 9) & 1) << 5)); }
__host__ __device__ __forceinline__ void stage_rc(int b, int& Rr, int& C) { const int st = b / 1024, sb = b % 1024, swz = sb ^ (((sb >> 9) & 1) << 5); Rr = (st >> 1) * 16 + swz / 64; C = (st & 1) * 32 + (swz % 64) / 2; }
__host__ __device__ __forceinline__ int perm32(int rho) { const int n = rho >> 4, i = rho & 15; return 8 * (i >> 2) + 4 * n + (i & 3); }

struct GU { const char* a; const char* b0; const char* b1; int r0; int c0; int ex; int half; };

struct TileOrder {
    int nM, nN, nwg, G, c;
    __device__ void init(int nM_, int nN_, int G_, int c_) { nM = nM_; nN = nN_; nwg = nM * nN; G = G_; c = c_; }
    __device__ bool tile(int i, int& pm, int& pn) const {
        const long Lx = (long)i * G + c; if (Lx >= nwg) return false;
        int wgid = (int)Lx; { const int q = nwg / NXCD, r = nwg % NXCD, xcd = wgid % NXCD, off = wgid / NXCD; wgid = (xcd < r ? xcd * (q + 1) : r * (q + 1) + (xcd - r) * q) + off; }
        const int nig = WGM * nN, gid = wgid / nig, fm = gid * WGM, gsz = (nM - fm) < WGM ? (nM - fm) : WGM;
        pm = fm + ((wgid % nig) % gsz); pn = (wgid % nig) / gsz; return true;
    }
};

template <class Epi, class Sched, bool GATHER, int BMODE = 0>
__device__ __forceinline__ void gemm_phase(LAS unsigned char* lds, const int K, const Sched& S, const Epi& E) {
    const int tid = opaque_tid(), wid = __builtin_amdgcn_readfirstlane(tid >> 6), lane = tid & 63, wr = wid >> 2, wc = wid & 3, fr = lane & 15, fq = lane >> 4;
    const int nt = K / BK;
    unsigned voffB[2], vAc[2][2], vAn[2][2];
#pragma unroll
    for (int i = 0; i < 2; ++i) { int Rr_, Cc_; stage_rc(tid * 16 + i * 8192, Rr_, Cc_); const int Rb = Epi::PERM ? ((Rr_ & ~31) + perm32(Rr_ & 31)) : Rr_;
        if constexpr (BMODE == 0) voffB[i] = (unsigned)(Rb * K + Cc_) * 2u;
        else { static_assert(BMODE == 0 || !Epi::PERM, "BMODE 1 needs PERM == false"); const int c = wid * 64 + i * 512 + lane, k = c >> 4, slot = c & 15, ch = slot ^ (((k & 3) << 2) | ((k >> 2) & 3));
            voffB[i] = (unsigned)k * (unsigned)S.ldb + (unsigned)ch * 16u; } }
    const size_t kstep = (size_t)(BK * 2);
    size_t kstepB = kstep; if constexpr (BMODE == 1) kstepB = (size_t)BK * (size_t)S.ldb;
    unsigned tb[2][2];
    if constexpr (BMODE == 1) { const int q = fr >> 2, pq = fr & 3;
#pragma unroll
        for (int n = 0; n < 2; ++n)
#pragma unroll
            for (int t = 0; t < 2; ++t) { const int row = 8 * fq + 4 * t + q, chunk = wc * 4 + 2 * n + (pq >> 1), swz = (q << 2) | ((2 * fq + t) & 3);
                tb[n][t] = (unsigned)(size_t)lds + (unsigned)(4 * HTB + 256 * row + 16 * (chunk ^ swz) + 8 * (pq & 1)); } }
    const unsigned ldsw = (unsigned)wid * 1024u;
    const int aoff = lds_byte(wr * 64 + fr, fq * 8), boff = lds_byte(wc * 32 + fr, fq * 8);
#define PG8_SA(b, h) (((b) * 2 + (h)) * HTB)
#define PG8_SB(b, h) ((4 + (b) * 2 + (h)) * HTB)
#define PG8_STAGE(bufoff, gbase, voff) do { _Pragma("unroll") for (int _i = 0; _i < 2; ++_i) \
        __builtin_amdgcn_global_load_lds((const unsigned*)((const char*)(gbase) + (voff)[_i]), (LAS unsigned*)(lds + (bufoff) + ldsw + _i * 8192), 16, 0, 0); } while (0)
#define PG8_LDA(dst, b, h) do { _Pragma("unroll") for (int m = 0; m < 4; ++m) _Pragma("unroll") for (int k = 0; k < 2; ++k) dst[m][k] = *(const LAS bf16x8*)(lds + PG8_SA(b, h) + aoff + m * 2048 + k * 1024); } while (0)
#define PG8_TR1(dstv, n, k, b, h) do { bf16x4 _lo, _hi; \
            asm volatile("ds_read_b64_tr_b16 %0, %1 offset:%2" : "=v"(_lo) : "v"(tb[n][0]), "i"((((b) * 2 + (h)) * 16384 + (k) * 8192)) : "memory"); \
            asm volatile("ds_read_b64_tr_b16 %0, %1 offset:%2" : "=v"(_hi) : "v"(tb[n][1]), "i"((((b) * 2 + (h)) * 16384 + (k) * 8192)) : "memory"); \
            dstv = __builtin_shufflevector(_lo, _hi, 0, 1, 2, 3, 4, 5, 6, 7); } while (0)
#define PG8_LDB(dst, b, h) do { if constexpr (BMODE == 0) { _Pragma("unroll") for (int n = 0; n < 2; ++n) _Pragma("unroll") for (int k = 0; k < 2; ++k) dst[n][k] = *(const LAS bf16x8*)(lds + PG8_SB(b, h) + boff + n * 2048 + k * 1024); } \
        else { PG8_TR1(dst[0][0], 0, 0, b, h); PG8_TR1(dst[0][1], 0, 1, b, h); PG8_TR1(dst[1][0], 1, 0, b, h); PG8_TR1(dst[1][1], 1, 1, b, h); } } while (0)
#define PG8_MMA(ai, bj, At, Bt) do { __builtin_amdgcn_s_setprio(1); _Pragma("unroll") for (int m = 0; m < 4; ++m) _Pragma("unroll") for (int n = 0; n < 2; ++n) _Pragma("unroll") for (int k = 0; k < 2; ++k) \
        acc[ai][bj][m][n] = __builtin_amdgcn_mfma_f32_16x16x32_bf16(Bt[n][k], At[m][k], acc[ai][bj][m][n], 0, 0, 0); __builtin_amdgcn_s_setprio(0); } while (0)
#define PG8_STAGE_A2(bufoff, gbase, h) do { if (GATHER && last) PG8_STAGE(bufoff, gbase, vAn[h]); else PG8_STAGE(bufoff, gbase, vAc[h]); } while (0)
#define PG8_WAIT_V(n) asm volatile("s_waitcnt vmcnt(" #n ")" ::: "memory")
#define PG8_WAIT_L(n) asm volatile("s_waitcnt lgkmcnt(" #n ")" ::: "memory")
#define PG8_BAR __builtin_amdgcn_s_barrier()
#define PG8_SCHED __builtin_amdgcn_sched_barrier(0)
#define PG8_AOFF(u, v) do { const int _t = opaque_tid(); _Pragma("unroll") for (int _i = 0; _i < 2; ++_i) { int _R, _C; stage_rc(_t * 16 + _i * 8192, _R, _C); _Pragma("unroll") for (int _h = 0; _h < 2; ++_h) \
        (v)[_h][_i] = GATHER ? ((unsigned)S.row((u), _h * 128 + _R) * (unsigned)K + (unsigned)_C) * 2u : ((unsigned)(_h * 128 + _R) * (unsigned)K + (unsigned)_C) * 2u; } } while (0)
    GU cur, nxt; int ui = 0;
    if (!S.next(0, cur)) return;
    f32x4 acc[2][2][4][2];
#pragma unroll
    for (int a = 0; a < 2; ++a)
#pragma unroll
        for (int b = 0; b < 2; ++b)
#pragma unroll
            for (int m = 0; m < 4; ++m)
#pragma unroll
                for (int n = 0; n < 2; ++n) acc[a][b][m][n] = (f32x4){0.f, 0.f, 0.f, 0.f};
    bf16x8 At[4][2], B0[2][2], B1[2][2];
    PG8_AOFF(cur, vAc);
    if (GATHER) { VM_WAIT(); }
    const char* cA = cur.a; const char* cB0 = cur.b0; const char* cB1 = cur.b1;
    PG8_STAGE(PG8_SB(0, 0), cB0, voffB); PG8_STAGE(PG8_SB(0, 1), cB1, voffB); PG8_STAGE(PG8_SA(0, 0), cA, vAc[0]); PG8_STAGE(PG8_SA(0, 1), cA, vAc[1]);
    if (wr == 1) PG8_BAR;
    PG8_WAIT_V(2); PG8_BAR;
    PG8_STAGE(PG8_SB(1, 0), cB0 + kstepB, voffB); PG8_STAGE(PG8_SA(1, 0), cA + kstep, vAc[0]); PG8_STAGE(PG8_SB(1, 1), cB1 + kstepB, voffB);
    PG8_WAIT_V(6); PG8_BAR;
    for (;;) {
        const bool has_next = S.next(ui + 1, nxt);
        const bool skip0 = (cur.half >= 2) && (wr == 1);
        const char* nA = has_next ? nxt.a : cA; const char* nB0 = has_next ? nxt.b0 : cB0; const char* nB1 = has_next ? nxt.b1 : cB1;
        for (int t = 0; t < nt; t += 2) {
            const bool last = (t == nt - 2);
            const char* a1 = cA + (size_t)(t + 1) * kstep;
            const char* a2 = last ? nA : cA + (size_t)(t + 2) * kstep;
            const char* b20 = last ? nB0 : cB0 + (size_t)(t + 2) * kstepB; const char* b21 = last ? nB1 : cB1 + (size_t)(t + 2) * kstepB;
            const char* a3 = a2 + kstep; const char* b30 = b20 + kstepB; const char* b31 = b21 + kstepB;
            if (GATHER && last) { if (has_next) { PG8_AOFF(nxt, vAn); } else {
#pragma unroll
                for (int h = 0; h < 2; ++h)
#pragma unroll
                    for (int i = 0; i < 2; ++i) vAn[h][i] = vAc[h][i]; } }
            PG8_LDB(B0, 0, 0); PG8_LDB(B1, 0, 1); PG8_SCHED; PG8_LDA(At, 0, 0); PG8_STAGE(PG8_SA(1, 1), a1, vAc[1]);
            PG8_WAIT_V(8); PG8_WAIT_L(0); PG8_BAR; if (!skip0) { PG8_MMA(0, 0, At, B0); PG8_MMA(0, 1, At, B1); } PG8_BAR; PG8_SCHED;
            PG8_LDA(At, 0, 1); PG8_STAGE(PG8_SB(0, 0), b20, voffB); PG8_STAGE(PG8_SB(0, 1), b21, voffB); PG8_STAGE_A2(PG8_SA(0, 0), a2, 0);
            PG8_WAIT_V(8); PG8_WAIT_L(0); PG8_BAR; if (!cur.half) { PG8_MMA(1, 0, At, B0); PG8_MMA(1, 1, At, B1); } PG8_BAR; PG8_SCHED;
            PG8_LDB(B0, 1, 0); PG8_LDB(B1, 1, 1); PG8_SCHED; PG8_LDA(At, 1, 0); PG8_STAGE_A2(PG8_SA(0, 1), a2, 1);
            PG8_WAIT_V(8); PG8_WAIT_L(0); PG8_BAR; if (!skip0) { PG8_MMA(0, 0, At, B0); PG8_MMA(0, 1, At, B1); } PG8_BAR; PG8_SCHED;
            PG8_LDA(At, 1, 1); PG8_STAGE(PG8_SB(1, 0), b30, voffB); PG8_STAGE(PG8_SB(1, 1), b31, voffB); PG8_STAGE_A2(PG8_SA(1, 0), a3, 0);
            PG8_WAIT_V(8); PG8_WAIT_L(0); PG8_BAR; if (!cur.half) { PG8_MMA(1, 0, At, B0); PG8_MMA(1, 1, At, B1); } PG8_BAR; PG8_SCHED;
        }
        if (wr == 0) PG8_BAR;
        E(acc, cur, wr, wc, fr, fq);
        if (!has_next) break;
#pragma unroll
        for (int a = 0; a < 2; ++a)
#pragma unroll
            for (int b = 0; b < 2; ++b)
#pragma unroll
                for (int m = 0; m < 4; ++m)
#pragma unroll
                    for (int n = 0; n < 2; ++n) acc[a][b][m][n] = (f32x4){0.f, 0.f, 0.f, 0.f};
        cur = nxt; cA = nA; cB0 = nB0; cB1 = nB1; ++ui;
        if (GATHER) {
#pragma unroll
            for (int h = 0; h < 2; ++h)
#pragma unroll
                for (int i = 0; i < 2; ++i) vAc[h][i] = vAn[h][i]; }
        if (wr == 1) PG8_BAR;
    }
    PG8_WAIT_V(0);
    PG8_BAR;
#undef PG8_SA
#undef PG8_SB
#undef PG8_STAGE
#undef PG8_LDA
#undef PG8_LDB
#undef PG8_TR1
#undef PG8_MMA
#undef PG8_WAIT_V
#undef PG8_WAIT_L
#undef PG8_BAR
#undef PG8_SCHED
#undef PG8_AOFF
#undef PG8_STAGE_A2
}
}
struct Params {
    const float* x; const float* meta; const float* lbl; const float* nmw; const float* w_in; const float* hgnw; const float* mbi; const float* mbf; const float* mlnw;
    const float* cw; const float* cb; const float* dtb; const float* alog; const float* dsk; const float* ssnw; const float* w_out; const float* nfw; const float* wg; const float* bg;
    const float* wr; const float* br; const float* w1; const float* w3; const float* w2; const float* fnw;
    float* out; unsigned char* ws;
};
constexpr size_t MiB = 1u << 20;
constexpr size_t al256(size_t x) { return (x + 255) / 256 * 256; }
constexpr size_t WS_CTL = 0, CTL_BYTES = 65536;
constexpr int CW_BAR = 0;
constexpr int CW_CNT = 4096;
constexpr size_t WS_WTIN  = WS_CTL + CTL_BYTES;
constexpr int NPROJX = NPROJ + 256;
constexpr size_t WS_WGIN  = WS_WTIN + al256((size_t)DEPTH * D * D_IN * 2);
constexpr size_t WS_WTOUT = WS_WGIN + al256((size_t)DEPTH * NGATE * D * 4);
constexpr size_t WS_WRT   = WS_WTOUT + al256((size_t)DEPTH * D * D * 2);
constexpr size_t WRF_LAYER = (size_t)64 * 3 * 2 * 64 * 8;
constexpr size_t WS_H0    = WS_WRT + al256((size_t)DEPTH * WRF_LAYER * 2);
constexpr size_t WS_H1    = WS_H0 + al256((size_t)R * D * 4);
constexpr size_t WS_U     = WS_H1 + al256((size_t)R * D * 4);
constexpr size_t WS_PROJ  = WS_U + al256((size_t)R * D * 2);
constexpr size_t WS_GATES = WS_PROJ + al256((size_t)R * NPROJ * 2);
constexpr size_t WS_MIXED = WS_GATES + al256((size_t)R * NGATE * 4);
constexpr size_t WS_COMMON_END = WS_MIXED + al256((size_t)R * D * 2);
constexpr int LDS_BYTES = 147456;
constexpr int LDS_BARW = LDS_BYTES - 64;
constexpr int LDS_PARAMS = LDS_BYTES - 64 - 256;
constexpr int LDS_QSLOT = LDS_PARAMS + 8 * 28;
__device__ __forceinline__ const void* lds_ptr(LAS unsigned char* lds, int i) {
    const u32x2 w = *(const LAS u32x2*)(lds + LDS_PARAMS + 8 * i);
    const unsigned lo = __builtin_amdgcn_readfirstlane(w.x), hi = __builtin_amdgcn_readfirstlane(w.y);
    GAS const void* g = (GAS const void*)(((unsigned long long)hi << 32) | lo);
    return (const void*)g;
}
__device__ __forceinline__ void p0_stream_convert(const float* src, bf16_t* dst, size_t n8, size_t gt, size_t NGT) {
#pragma unroll 4
    for (size_t i = gt; i < n8; i += NGT) {
        const f32x4 a = __builtin_nontemporal_load((const f32x4*)(src + i * 8)), b = __builtin_nontemporal_load((const f32x4*)(src + i * 8 + 4));
        u32x4 o; o.x = cvt_pk_bf16(a.x, a.y); o.y = cvt_pk_bf16(a.z, a.w); o.z = cvt_pk_bf16(b.x, b.y); o.w = cvt_pk_bf16(b.z, b.w);
        *(u32x4*)(dst + i * 8) = o;
    }
}
__device__ __forceinline__ void phase_p0(const Params& p, LAS unsigned char* lds) {
    (void)lds;
    const int tid = opaque_tid();
    const size_t gt = (size_t)blockIdx.x * NTHREADS + tid, NGT = (size_t)gridDim.x * NTHREADS;
    p0_stream_convert(p.w_in, (bf16_t*)(p.ws + WS_WTIN), (size_t)DEPTH * D * D_IN / 8, gt, NGT);
    p0_stream_convert(p.w_out, (bf16_t*)(p.ws + WS_WTOUT), (size_t)DEPTH * D * D / 8, gt, NGT);
    bf16_t* wrf = (bf16_t*)(p.ws + WS_WRT);
    for (int i = (int)gt; i < DEPTH * 64 * 3 * 64; i += (int)NGT) {
        const int l = i / (64 * 3 * 64), ks = (i / (3 * 64)) % 64, ct = (i / 64) % 3, ln = i % 64;
        const int col = ct * 16 + (ln & 15);
        float hi[8], lo[8];
#pragma unroll
        for (int j = 0; j < 8; ++j) { const int k = ks * 32 + (ln >> 4) * 8 + j;
            float v = 0.f;
            if (col < 4) v = p.wg[((size_t)l * D + k) * 4 + col];
            else if (col < 36) { const int e = col - 4, g = e >> 3, ee = e & 7; v = p.wr[(((size_t)l * 4 + g) * D + k) * 8 + ee]; }
            v *= p.nfw[(size_t)l * D + k];
            hi[j] = bf2f(f2bf(v)); lo[j] = v - hi[j]; }
        bf16_t* dst = wrf + (size_t)l * WRF_LAYER + ((((size_t)ks * 3 + ct) * 2) * 64 + ln) * 8;
        *(u32x4*)dst = pack8(hi); *(u32x4*)(dst + 64 * 8) = pack8(lo);
    }
}

struct N1Src { const float* hsrc; int layer_prev; int pad; };
template <int MODE>
__device__ __forceinline__ void n1_load_row(const Params& p, const N1Src& s, int excl, int r, int lane, f32x4 (&v)[8]);
__device__ __forceinline__ int combine_excl(const Params& p, int layer, int lane);

#ifndef N1_NT
#define N1_NT 0
#endif
#if N1_NT
#define N1_ST(v, p) __builtin_nontemporal_store((v), (p))
#define N1_LD(p) __builtin_nontemporal_load(p)
#else
#define N1_ST(v, p) (*(p) = (v))
#define N1_LD(p) (*(p))
#endif
template <int MODE>
__device__ __forceinline__ void phase_n1(const Params& p, int layer, const N1Src& src) {
    const int tid = opaque_tid(), lane = tid & 63, wave = __builtin_amdgcn_readfirstlane(tid >> 6);
    const int gw = blockIdx.x * NWAVES + wave, NGW = gridDim.x * NWAVES;
    float* h0 = (float*)(p.ws + WS_H0); bf16_t* U = (bf16_t*)(p.ws + WS_U);
    const float* wn = p.nmw + (size_t)layer * D;
    f32x4 wv[8];
#pragma unroll
    for (int j = 0; j < 8; ++j) wv[j] = *(const f32x4*)(wn + 4 * lane + 256 * j);
    const int excl = (MODE == 2) ? combine_excl(p, src.layer_prev, lane) : 0;
    for (int task = gw; task < R / 2; task += NGW) {
        f32x4 v[2][8];
#pragma unroll
        for (int q = 0; q < 2; ++q) n1_load_row<MODE>(p, src, excl, 2 * task + q, lane, v[q]);
#pragma unroll
        for (int q = 0; q < 2; ++q) {
            const int r = 2 * task + q;
            float ss = 0.f;
#pragma unroll
            for (int j = 0; j < 8; ++j) { if (MODE != 0) N1_ST(v[q][j], (f32x4*)(h0 + (size_t)r * D + 4 * lane + 256 * j)); ss += (v[q][j].x * v[q][j].x + v[q][j].y * v[q][j].y) + (v[q][j].z * v[q][j].z + v[q][j].w * v[q][j].w); }
            const float rs = rsqrtf(wave_sum(ss) * (1.f / D) + EPS);
#pragma unroll
            for (int j = 0; j < 8; ++j) { v[q][j] = v[q][j] * rs * wv[j];
                u32x2 o; o.x = cvt_pk_bf16(v[q][j].x, v[q][j].y); o.y = cvt_pk_bf16(v[q][j].z, v[q][j].w);
                *(u32x2*)(U + (size_t)r * D + 4 * lane + 256 * j) = o; }
        }
    }
}
template <>
__device__ __forceinline__ void n1_load_row<0>(const Params& p, const N1Src&, int, int r, int lane, f32x4 (&v)[8]) {
    const int b = r / PB, pp = r % PB;
    if (pp < LEADP) {
#pragma unroll
        for (int j = 0; j < 8; ++j) v[j] = (f32x4){0.f, 0.f, 0.f, 0.f};
    } else {
        const int l = pp - LEADP;
        const float* s = l < NMETA ? p.meta + (size_t)l * D : p.x + ((size_t)b * SEQ + (l - NMETA)) * D;
#pragma unroll
        for (int j = 0; j < 8; ++j) v[j] = *(const f32x4*)(s + 4 * lane + 256 * j);
    }
}
template <>
__device__ __forceinline__ void n1_load_row<1>(const Params& p, const N1Src& sr, int, int r, int lane, f32x4 (&v)[8]) {
    const int b = r / PB, pp = r % PB;
    if (pp < LEADP) {
#pragma unroll
        for (int j = 0; j < 8; ++j) v[j] = (f32x4){0.f, 0.f, 0.f, 0.f};
    } else {
        const float* s = sr.hsrc + ((size_t)b * LTOK + (pp - LEADP)) * D;
#pragma unroll
        for (int j = 0; j < 8; ++j) v[j] = *(const f32x4*)(s + 4 * lane + 256 * j);
    }
}

struct SchedPlain {
    static constexpr int ldb = 0;
    pg8::TileOrder T; const char* A; const char* Bt; int K;
    __device__ bool next(int i, pg8::GU& u) const { int pm, pn; if (!T.tile(i, pm, pn)) return false;
        u.a = A + (size_t)pm * 256 * K * 2; u.b0 = Bt + (size_t)pn * 256 * K * 2; u.b1 = u.b0 + (size_t)128 * K * 2; u.r0 = pm * 256; u.c0 = pn * 256; u.ex = 0; u.half = 0; return true; }
    __device__ int row(const pg8::GU&, int) const { return 0; }
};
struct EpiBf16Store {
    static constexpr bool PERM = true;
    bf16_t* O; int ldc;
    __device__ __forceinline__ void operator()(const f32x4 (&acc)[2][2][4][2], const pg8::GU& u, int wr, int wc, int fr, int fq) const {
        const int row0 = u.r0 + wr * 64 + fr, col0 = u.c0 + wc * 32 + 8 * fq;
#pragma unroll
        for (int ai = 0; ai < 2; ++ai)
#pragma unroll
            for (int m = 0; m < 4; ++m) { bf16_t* rowp = O + (size_t)(row0 + ai * 128 + m * 16) * ldc + col0;
#pragma unroll
                for (int bj = 0; bj < 2; ++bj) { const f32x4 v0 = acc[ai][bj][m][0], v1 = acc[ai][bj][m][1];
                    u32x4 w; w.x = cvt_pk_bf16(v0[0], v0[1]); w.y = cvt_pk_bf16(v0[2], v0[3]); w.z = cvt_pk_bf16(v1[0], v1[1]); w.w = cvt_pk_bf16(v1[2], v1[3]);
                    *(u32x4*)(rowp + bj * 128) = w; } }
    }
};
#ifndef NT_EPI
#define NT_EPI 0
#endif
#if NT_EPI
#define NT_STORE(v, p) __builtin_nontemporal_store((v), (p))
#else
#define NT_STORE(v, p) (*(p) = (v))
#endif
struct SchedG1 {
    static constexpr int ldb = D_IN * 2;
    pg8::TileOrder T; const char* A; const char* W;
    __device__ bool next(int i, pg8::GU& u) const { int pm, pn; if (!T.tile(i, pm, pn)) return false;
        u.a = A + (size_t)pm * 256 * D * 2; u.r0 = pm * 256; u.c0 = pn * 256; u.ex = 0; u.half = 0;
        if (pn < NPROJ / 256) { const int sc = u.c0 < 3584 ? u.c0 : u.c0 + 8; u.b0 = W + (size_t)sc * 2; u.b1 = u.b0 + 256; }
        else { u.b0 = W + (size_t)3584 * 2; u.b1 = W + (size_t)6664 * 2; }
        return true; }
    __device__ int row(const pg8::GU&, int) const { return 0; }
};
struct EpiProj {
    static constexpr bool PERM = false;
    bf16_t* O; float* G;
    __device__ __forceinline__ void operator()(const f32x4 (&acc)[2][2][4][2], const pg8::GU& u, int wr, int wc, int fr, int fq) const {
        const int row0 = u.r0 + wr * 64 + fr;
        if (u.c0 < NPROJ) {
            const int col0 = u.c0 + wc * 32 + 4 * fq;
#pragma unroll
            for (int ai = 0; ai < 2; ++ai) if (ai == 0 || !u.half)
#pragma unroll
                for (int m = 0; m < 4; ++m) { bf16_t* rowp = O + (size_t)(row0 + ai * 128 + m * 16) * NPROJ + col0;
#pragma unroll
                    for (int bj = 0; bj < 2; ++bj)
#pragma unroll
                        for (int n = 0; n < 2; ++n) { const f32x4 v = acc[ai][bj][m][n]; u32x2 o; o.x = cvt_pk_bf16(v[0], v[1]); o.y = cvt_pk_bf16(v[2], v[3]); NT_STORE(o, (u32x2*)(rowp + bj * 128 + n * 16)); } }
        } else if (wc == 0) {
#pragma unroll
            for (int ai = 0; ai < 2; ++ai) if (ai == 0 || !u.half)
#pragma unroll
                for (int m = 0; m < 4; ++m) { float* gp = G + (size_t)(row0 + ai * 128 + m * 16) * NGATE;
                    if (fq < 2) *(f32x4*)(gp + 4 * fq) = acc[ai][0][m][0];
                    *(f32x4*)(gp + 8 + 4 * fq) = acc[ai][1][m][0]; }
        }
    }
};
__device__ __forceinline__ void phase_g1(const Params& p, int layer, LAS unsigned char* lds) {
    SchedG1 S; S.T.init(R / 256, NPROJX / 256, gridDim.x, blockIdx.x); S.A = (const char*)(p.ws + WS_U); S.W = (const char*)(p.ws + WS_WTIN) + (size_t)layer * D * D_IN * 2;
    EpiProj E{(bf16_t*)(p.ws + WS_PROJ), (float*)(p.ws + WS_GATES)};
    pg8::gemm_phase<EpiProj, SchedG1, false, 1>(lds, D, S, E);
}
constexpr size_t WS_ST_S  = WS_COMMON_END;
constexpr size_t WS_ST_M  = WS_ST_S + al256((size_t)NCH * 16 * 8192 * 2);
constexpr size_t WS_ST_H  = WS_ST_M + al256((size_t)NCH * 4 * 8192 * 2);
constexpr size_t WS_DEC_S = WS_ST_H + al256((size_t)NCH * 4 * 16384 * 2);
constexpr size_t WS_NV_M  = WS_DEC_S + al256((size_t)NCH * 16 * 4);
constexpr size_t WS_SC_M  = WS_NV_M + al256((size_t)NCH * 4 * 64 * 4);
constexpr size_t WS_DEC_H = WS_SC_M + al256((size_t)NCH * 4 * 2 * 4);
constexpr size_t WS_MP_M  = WS_DEC_H + al256((size_t)NCH * 4 * 128 * 4);
constexpr size_t WS_MIX_END = WS_MP_M + al256((size_t)NCH * 4 * 4);

__device__ __forceinline__ f32x4 mfma16(bf16x8 a, bf16x8 b, f32x4 c) { return __builtin_amdgcn_mfma_f32_16x16x32_bf16(a, b, c, 0, 0, 0); }
template <int P> __device__ __forceinline__ bf16x8 frag_row(LAS const unsigned char* base, int row0, int k0, int fr, int fq) {
    return *(const LAS bf16x8*)(base + (row0 + fr) * P + (k0 + 8 * fq) * 2);
}
template <int P> __device__ __forceinline__ bf16x8 frag_tr(LAS const unsigned char* base, int k0, int col0, int lane) {
    const int g = lane >> 4, q = (lane & 15) >> 2, pp = lane & 3;
    const unsigned a = (unsigned)(size_t)base + (unsigned)((k0 + 8 * g + q) * P + (col0 + 4 * pp) * 2);
    bf16x4 lo, hi;
    asm volatile("ds_read_b64_tr_b16 %0, %2\n\tds_read_b64_tr_b16 %1, %2 offset:%3\n\ts_waitcnt lgkmcnt(0)" : "=&v"(lo), "=&v"(hi) : "v"(a), "i"(4 * P) : "memory");
    bf16x8 r; r[0] = lo[0]; r[1] = lo[1]; r[2] = lo[2]; r[3] = lo[3]; r[4] = hi[0]; r[5] = hi[1]; r[6] = hi[2]; r[7] = hi[3];
    return r;
}
__device__ __forceinline__ float wave_scan_incl(float v, int lane) {
#pragma unroll
    for (int o = 1; o < 64; o <<= 1) { const float t = __shfl_up(v, o); if (lane >= o) v += t; }
    return v;
}
__device__ __forceinline__ float wave_scan_max_incl(float v, int lane) {
#pragma unroll
    for (int o = 1; o < 64; o <<= 1) { const float t = __shfl_up(v, o); if (lane >= o) v = fmaxf(v, t); }
    return v;
}
__device__ __forceinline__ float wave_max(float v) {
#pragma unroll
    for (int o = 1; o < 64; o <<= 1) v = fmaxf(v, __shfl_xor(v, o));
    return v;
}
template <int KS> __device__ __forceinline__ int frag_off4(int n, int kbase) {
    return (((n >> 4) * KS + (kbase >> 5)) * 64 + ((kbase & 31) >> 3) * 16 + (n & 15)) * 8 + (kbase & 7);
}

#ifndef SCAN_NT
#define SCAN_NT 0
#endif
#if SCAN_NT
#define SCAN_LD(p) __builtin_nontemporal_load(p)
#else
#define SCAN_LD(p) (*(p))
#endif
#ifndef PROBE_D
#define PROBE_D d
#endif
#ifndef PROBE_L
#define PROBE_L 1.f
#endif
#ifndef SSD_RPT_CONV
#define SSD_RPT_CONV 1
#endif
#ifndef SSD_RPT_S3
#define SSD_RPT_S3 1
#endif
#ifndef SSD_RPT_S4
#define SSD_RPT_S4 1
#endif
#ifndef SSD_RPT_EPI
#define SSD_RPT_EPI 1
#endif
#ifndef SSD_RPT_GATES
#define SSD_RPT_GATES 1
#endif
namespace ssd {
constexpr int PC = 272, PX = 528, PM = 144;
constexpr int OFF_C = 0, OFF_B = 64 * PC, OFF_X = OFF_B + 64 * PC, OFF_M = OFF_X + 64 * PX, OFF_CUM = OFF_M + 4 * 64 * PM, OFF_END = OFF_CUM + 3 * 4 * 64 * 4;
constexpr int PY = 260;
static_assert(OFF_B + 64 * PY * 4 <= OFF_CUM, "Y staging overlays B, X, M");

__device__ __forceinline__ void gates(const Params& p, int layer, LAS unsigned char* lds, int c, int g, bool phaseA) {
    const int tid = opaque_tid(), lane = tid & 63, wave = __builtin_amdgcn_readfirstlane(tid >> 6);
    LAS float* cum = (LAS float*)(lds + OFF_CUM); LAS float* dtv = cum + 256; LAS float* wend = cum + 512;
    if (wave < 4) {
        const int hd = 4 * g + wave, row = c * 64 + lane, pp = row % PB;
        const float* gates = (const float*)(p.ws + WS_GATES);
        float dt = 0.f;
        if (pp >= LEADP) dt = softplusf_(gates[(size_t)row * NGATE + 8 + hd] + p.dtb[layer * 16 + hd]);
        const float a = -__expf(p.alog[layer * 16 + hd]);
        const float cs = wave_scan_incl(dt * a, lane);
        const float last = __shfl(cs, 63);
        cum[wave * 64 + lane] = cs; dtv[wave * 64 + lane] = dt; wend[wave * 64 + lane] = __expf(last - cs);
        if (phaseA && lane == 0) ((float*)(p.ws + WS_DEC_S))[c * 16 + hd] = __expf(last);
    }
}
struct ConvRegs { u32x4 raw[11]; f32x4 w[4][2]; f32x4 b[2]; };
__device__ __forceinline__ void conv_load(const Params& p, int layer, int c, int g, int ncg, ConvRegs& Rg) {
    const int tid = opaque_tid(), cg = tid & 63, rb = tid >> 6;
    const int cgc = cg < ncg ? cg : 0;
    const int n = c % CPB;
    const int ci = cgc < 32 ? g * 256 + cgc * 8 : (cgc < 48 ? 1024 + g * 128 + (cgc - 32) * 8 : 1536 + g * 128 + (cgc - 48) * 8);
    const float* cw = p.cw + (size_t)layer * 4 * 2048 + ci; const float* cb = p.cb + (size_t)layer * 2048 + ci;
#pragma unroll
    for (int t = 0; t < 4; ++t) { Rg.w[t][0] = *(const f32x4*)(cw + t * 2048); Rg.w[t][1] = *(const f32x4*)(cw + t * 2048 + 4); }
    Rg.b[0] = *(const f32x4*)cb; Rg.b[1] = *(const f32x4*)(cb + 4);
    const bf16_t* src = (const bf16_t*)(p.ws + WS_PROJ) + (size_t)(c * 64) * NPROJ + P_SX + ci;
#pragma unroll
    for (int i = 0; i < 11; ++i) { const int s = rb * 8 - 3 + i;
        if (s < 0 && n == 0) Rg.raw[i] = (u32x4){0u, 0u, 0u, 0u}; else Rg.raw[i] = *(const u32x4*)(src + (ptrdiff_t)s * NPROJ); }
}
__device__ __forceinline__ void conv_compute(LAS unsigned char* lds, int ncg, LAS const float* xs0, LAS const float* xs1, const ConvRegs& Rg, bf16_t* gdst, int gch) {
    const int tid = opaque_tid(), cg = tid & 63, rb = tid >> 6;
    if (cg >= ncg) return;
    int loff, pitch;
    if (cg < 32) { loff = OFF_X + cg * 16; pitch = PX; } else if (cg < 48) { loff = OFF_B + (cg - 32) * 16; pitch = PC; } else { loff = OFF_C + (cg - 48) * 16; pitch = PC; }
    const float w[4][8] = {{Rg.w[0][0].x, Rg.w[0][0].y, Rg.w[0][0].z, Rg.w[0][0].w, Rg.w[0][1].x, Rg.w[0][1].y, Rg.w[0][1].z, Rg.w[0][1].w},
                           {Rg.w[1][0].x, Rg.w[1][0].y, Rg.w[1][0].z, Rg.w[1][0].w, Rg.w[1][1].x, Rg.w[1][1].y, Rg.w[1][1].z, Rg.w[1][1].w},
                           {Rg.w[2][0].x, Rg.w[2][0].y, Rg.w[2][0].z, Rg.w[2][0].w, Rg.w[2][1].x, Rg.w[2][1].y, Rg.w[2][1].z, Rg.w[2][1].w},
                           {Rg.w[3][0].x, Rg.w[3][0].y, Rg.w[3][0].z, Rg.w[3][0].w, Rg.w[3][1].x, Rg.w[3][1].y, Rg.w[3][1].z, Rg.w[3][1].w}};
    const float bias[8] = {Rg.b[0].x, Rg.b[0].y, Rg.b[0].z, Rg.b[0].w, Rg.b[1].x, Rg.b[1].y, Rg.b[1].z, Rg.b[1].w};
    const int hd = cg >> 3;
    float r0[8], r1[8], r2[8], r3[8];
    unpack8(Rg.raw[0], r0); unpack8(Rg.raw[1], r1); unpack8(Rg.raw[2], r2);
#pragma unroll
    for (int i = 0; i < 8; ++i) {
        const int s = rb * 8 + i;
        unpack8(Rg.raw[3 + i], r3);
        float o[8];
        float sc = 1.f, sc2 = 1.f;
        if (cg < 32) { sc = xs0[hd * 64 + s]; if (xs1) sc2 = xs1[hd * 64 + s]; }
#pragma unroll
        for (int j = 0; j < 8; ++j) { const float a = bias[j] + w[0][j] * r0[j] + w[1][j] * r1[j] + w[2][j] * r2[j] + w[3][j] * r3[j]; o[j] = siluf_(a) * sc; }
        if (gdst) *(u32x4*)(gdst + (size_t)s * D + gch) = pack8(o);
        if (cg < 48) {
#pragma unroll
            for (int j = 0; j < 8; ++j) o[j] *= sc2;
            *(LAS u32x4*)(lds + loff + s * pitch) = pack8(o); }
#pragma unroll
        for (int j = 0; j < 8; ++j) { r0[j] = r1[j]; r1[j] = r2[j]; r2[j] = r3[j]; }
    }
}

__device__ __forceinline__ void phase_a(const Params& p, int layer, LAS unsigned char* lds, int c, int g) {
    const int tid = opaque_tid(), lane = tid & 63, wave = __builtin_amdgcn_readfirstlane(tid >> 6), fr = lane & 15, fq = lane >> 4;
    LAS float* cum = (LAS float*)(lds + OFF_CUM); LAS float* dtv = cum + 256; LAS float* wend = cum + 512;
    ConvRegs Rg; conv_load(p, layer, c, g, 64, Rg);
    gates(p, layer, lds, c, g, true);
    __syncthreads();
    { const int cg = tid & 63; const int ci = cg < 32 ? g * 256 + cg * 8 : (cg < 48 ? 1024 + g * 128 + (cg - 32) * 8 : 1536 + g * 128 + (cg - 48) * 8);
      conv_compute(lds, 64, dtv, wend, Rg, (bf16_t*)(p.ws + WS_U) + (size_t)(c * 64) * D, ci); }
    __syncthreads();
#ifdef PROBE_REFA
    for (int e = tid; e < 4 * 64 * 128; e += NTHREADS) {
        const int hh = e >> 13, pp_ = (e >> 7) & 63, k = e & 127;
        float a = 0.f;
        for (int s = 0; s < 64; ++s) a += bf2f(*(LAS bf16_t*)(lds + OFF_X + s * PX + (hh * 64 + pp_) * 2)) * bf2f(*(LAS bf16_t*)(lds + OFF_B + s * PC + k * 2));
        bf16_t* st2 = (bf16_t*)(p.ws + WS_ST_S) + ((size_t)c * 16 + 4 * g + hh) * 8192;
        st2[(((pp_ >> 4) * 4 + (k >> 5)) * 64 + ((k & 31) >> 3) * 16 + (pp_ & 15)) * 8 + (k & 7)] = f2bf(a);
    }
    __syncthreads();
    return;
#endif
    const int hd = wave >> 1;
    bf16_t* st = (bf16_t*)(p.ws + WS_ST_S) + ((size_t)c * 16 + 4 * g + hd) * 8192;
    bf16x8 xb[4][2];
#pragma unroll
    for (int pt = 0; pt < 4; ++pt)
#pragma unroll
        for (int ks = 0; ks < 2; ++ks) xb[pt][ks] = frag_tr<PX>(lds + OFF_X, ks * 32, hd * 64 + pt * 16, lane);
#pragma unroll
    for (int kk = 0; kk < 4; ++kk) {
        const int kt = 4 * (wave & 1) + kk;
        bf16x8 ba[2];
#pragma unroll
        for (int ks = 0; ks < 2; ++ks) ba[ks] = frag_tr<PC>(lds + OFF_B, ks * 32, kt * 16, lane);
#pragma unroll
        for (int pt = 0; pt < 4; ++pt) {
            f32x4 acc = (f32x4){0.f, 0.f, 0.f, 0.f};
#pragma unroll
            for (int ks = 0; ks < 2; ++ks) acc = mfma16(ba[ks], xb[pt][ks], acc);
            u32x2 o; o.x = cvt_pk_bf16(acc[0], acc[1]); o.y = cvt_pk_bf16(acc[2], acc[3]);
            *(u32x2*)(st + frag_off4<4>(pt * 16 + fr, kt * 16 + 4 * fq)) = o;
        }
    }
    __syncthreads();
}

__device__ __forceinline__ void phase_c(const Params& p, int layer, LAS unsigned char* lds, int c, int g) {
    const int tid = opaque_tid(), lane = tid & 63, wave = __builtin_amdgcn_readfirstlane(tid >> 6), fr = lane & 15, fq = lane >> 4;
    LAS float* cum = (LAS float*)(lds + OFF_CUM); LAS float* dtv = cum + 256;
    u32x4 xr[8];
    { const int cg = tid & 63, rb = tid >> 6; const int ci = cg < 32 ? g * 256 + cg * 8 : (cg < 48 ? 1024 + g * 128 + (cg - 32) * 8 : 1536 + g * 128 + (cg - 48) * 8);
      const bf16_t* xa = (const bf16_t*)(p.ws + WS_U) + (size_t)(c * 64 + rb * 8) * D + ci;
#pragma unroll
      for (int i = 0; i < 8; ++i) xr[i] = *(const u32x4*)(xa + (size_t)i * D); }
    const int hd = wave >> 1;
    bf16x8 sf[2][4];
    { const bf16_t* st = (const bf16_t*)(p.ws + WS_ST_S) + ((size_t)c * 16 + 4 * g + hd) * 8192;
#pragma unroll
      for (int pi = 0; pi < 2; ++pi)
#pragma unroll
          for (int ks = 0; ks < 4; ++ks) sf[pi][ks] = *(const bf16x8*)(st + (((2 * (wave & 1) + pi) * 4 + ks) * 64 + lane) * 8); }
    const bf16_t* proj = (const bf16_t*)(p.ws + WS_PROJ);
    u32x4 zr[4];
#pragma unroll
    for (int it = 0; it < 4; ++it) { const int item = it * 512 + tid; zr[it] = *(const u32x4*)(proj + (size_t)(c * 64 + (item >> 5)) * NPROJ + P_SZ + g * 256 + (item & 31) * 8); }
    gates(p, layer, lds, c, g, false);
    { const int cg = tid & 63, rb = tid >> 6; int loff, pitch;
      if (cg < 32) { loff = OFF_X + cg * 16; pitch = PX; } else if (cg < 48) { loff = OFF_B + (cg - 32) * 16; pitch = PC; } else { loff = OFF_C + (cg - 48) * 16; pitch = PC; }
#pragma unroll
      for (int i = 0; i < 8; ++i) *(LAS u32x4*)(lds + loff + (rb * 8 + i) * pitch) = xr[i]; }
    __syncthreads();
    for (int rp_ = 0; rp_ < SSD_RPT_S3; ++rp_)
    for (int ti = wave; ti < 12; ti += 8) {
        int tt, st; bool zero = false;
        if (ti < 10) { tt = ti < 1 ? 0 : ti < 3 ? 1 : ti < 6 ? 2 : 3; st = ti - (tt * (tt + 1)) / 2; }
        else { zero = true; tt = ti == 10 ? 0 : 2; st = tt + 1; }
        f32x4 acc = (f32x4){0.f, 0.f, 0.f, 0.f};
        if (!zero) {
#pragma unroll
            for (int ks = 0; ks < 4; ++ks) acc = mfma16(frag_row<PC>(lds + OFF_C, tt * 16, ks * 32, fr, fq), frag_row<PC>(lds + OFF_B, st * 16, ks * 32, fr, fq), acc);
        }
        const int s = st * 16 + fr, t0 = tt * 16 + 4 * fq;
        const bool diag = (tt == st);
#pragma unroll
        for (int hd = 0; hd < 4; ++hd) {
            const float cs = cum[hd * 64 + s];
            const f32x4 ct4 = *(const LAS f32x4*)(cum + hd * 64 + t0);
            f32x4 tm4 = (f32x4){0.f, 0.f, 0.f, 0.f};
            if (diag) { const f32x4 d4 = *(const LAS f32x4*)(dtv + hd * 64 + t0); const float dsk = p.dsk[layer * 16 + 4 * g + hd];
#pragma unroll
                for (int r = 0; r < 4; ++r) tm4[r] = d4[r] > 0.f ? dsk * __builtin_amdgcn_rcpf(d4[r]) : 0.f; }
#pragma unroll
            for (int r = 0; r < 4; ++r) {
                const int t = t0 + r;
                float v = acc[r] * __expf(ct4[r] - cs);
                v = (!zero && s <= t) ? v : 0.f;
                v += (diag && s == t) ? tm4[r] : 0.f;
                *(LAS bf16_t*)(lds + OFF_M + hd * 64 * PM + t * PM + s * 2) = f2bf(v);
            }
        }
    }
    __syncthreads();
    f32x4 y[2][4];
    for (int rp_ = 0; rp_ < SSD_RPT_S4; ++rp_)
    {
        bf16x8 xf[2][2];
#pragma unroll
        for (int pi = 0; pi < 2; ++pi) { const int pt = 2 * (wave & 1) + pi;
#pragma unroll
            for (int ks = 0; ks < 2; ++ks) xf[pi][ks] = frag_tr<PX>(lds + OFF_X, ks * 32, hd * 64 + pt * 16, lane); }
#pragma unroll
        for (int tt = 0; tt < 4; ++tt) {
            bf16x8 cf[4], mf[2];
#pragma unroll
            for (int ks = 0; ks < 4; ++ks) cf[ks] = frag_row<PC>(lds + OFF_C, tt * 16, ks * 32, fr, fq);
#pragma unroll
            for (int ks = 0; ks < 2; ++ks) mf[ks] = frag_row<PM>(lds + OFF_M + hd * 64 * PM, tt * 16, ks * 32, fr, fq);
            float ec[4];
#pragma unroll
            for (int r = 0; r < 4; ++r) ec[r] = __expf(cum[hd * 64 + tt * 16 + 4 * fq + r]);
#pragma unroll
            for (int pi = 0; pi < 2; ++pi) {
                f32x4 acc = (f32x4){0.f, 0.f, 0.f, 0.f};
#pragma unroll
                for (int ks = 0; ks < 4; ++ks) acc = mfma16(cf[ks], sf[pi][ks], acc);
#pragma unroll
                for (int r = 0; r < 4; ++r) acc[r] *= ec[r];
#ifdef PROBE_NOOFF
                acc = (f32x4){0.f, 0.f, 0.f, 0.f};
#endif
#ifndef PROBE_NODIAG
                acc = mfma16(mf[0], xf[pi][0], acc);
                if (tt >= 2) acc = mfma16(mf[1], xf[pi][1], acc);
#endif
                y[pi][tt] = acc;
            }
        }
    }
    __syncthreads();
    LAS float* Y = (LAS float*)(lds + OFF_B);
#pragma unroll
    for (int pi = 0; pi < 2; ++pi)
#pragma unroll
        for (int tt = 0; tt < 4; ++tt)
#pragma unroll
            for (int r = 0; r < 4; ++r) Y[(tt * 16 + 4 * fq + r) * PY + hd * 64 + (2 * (wave & 1) + pi) * 16 + fr] = y[pi][tt][r];
    __syncthreads();
    bf16_t* mixed = (bf16_t*)(p.ws + WS_MIXED);
    const float* nw = p.ssnw + (size_t)layer * 1024 + g * 256;
    for (int rp_ = 0; rp_ < SSD_RPT_EPI; ++rp_)
#pragma unroll
    for (int it = 0; it < 4; ++it) {
        const int item = it * 512 + tid, rloc = item >> 5, cgp = item & 31, row = c * 64 + rloc;
        float z[8], v[8];
        unpack8(zr[it], z);
        float ss = 0.f;
#pragma unroll
        for (int j = 0; j < 8; ++j) { v[j] = Y[rloc * PY + cgp * 8 + j] * siluf_(z[j]); ss += v[j] * v[j]; }
        ss = sum32_dpp(ss, lane);
        const float rs = rsqrtf(ss * (1.f / 256.f) + EPS);
        const f32x4 w0 = *(const f32x4*)(nw + cgp * 8), w1 = *(const f32x4*)(nw + cgp * 8 + 4);
        v[0] *= rs * w0.x; v[1] *= rs * w0.y; v[2] *= rs * w0.z; v[3] *= rs * w0.w; v[4] *= rs * w1.x; v[5] *= rs * w1.y; v[6] *= rs * w1.z; v[7] *= rs * w1.w;
#ifdef PROBE_ZERO
        for (int j = 0; j < 8; ++j) v[j] = 0.f;
#endif
        *(u32x4*)(mixed + (size_t)row * D + 1024 + g * 256 + cgp * 8) = pack8(v);
    }
    __syncthreads();
}

__device__ __forceinline__ void scan_item(const Params& p, int item) {
    const int e8 = item & 1023, bh = __builtin_amdgcn_readfirstlane(item >> 10), b = bh >> 4, hd = bh & 15;
    bf16_t* base = (bf16_t*)(p.ws + WS_ST_S) + ((size_t)(b * CPB) * 16 + hd) * 8192 + e8 * 8;
    const float* dec = (const float*)(p.ws + WS_DEC_S) + (b * CPB) * 16 + hd;
    u32x4 loc[CPB];
#pragma unroll
    for (int n = 0; n < CPB; ++n) loc[n] = SCAN_LD((const u32x4*)(base + (size_t)n * 16 * 8192));
    float S[8];
#pragma unroll
    for (int j = 0; j < 8; ++j) S[j] = 0.f;
#pragma unroll
    for (int n = 0; n < CPB; ++n) {
        const float d = dec[n * 16];
        float l[8]; unpack8(loc[n], l);
        *(u32x4*)(base + (size_t)n * 16 * 8192) = pack8(S);
#pragma unroll
        for (int j = 0; j < 8; ++j) S[j] = d * S[j] + l[j];
    }
}
}
namespace mls {
constexpr int PQ = 144, PV = 304, PP = 144;
constexpr int OFF_Q = 0, OFF_K = 64 * PQ, OFF_V = OFF_K + 64 * PQ, OFF_P = OFF_V + 64 * PV, OFF_G = OFF_P + 64 * PP, OFF_END = OFF_G + 6 * 64 * 4;
constexpr int PY = 148;
constexpr int OFF_Y = OFF_END;
constexpr float NEGV = -1e30f;

__device__ __forceinline__ void gates(const Params& p, int layer, LAS unsigned char* lds, int c, int h, bool phaseA) {
    const int tid = opaque_tid(), lane = tid & 63, wave = __builtin_amdgcn_readfirstlane(tid >> 6);
    LAS float* G = (LAS float*)(lds + OFF_G);
    if (wave == 0) {
        const int row = c * 64 + lane, pp = row % PB;
        const float* gates = (const float*)(p.ws + WS_GATES);
        float li = NEGV, lf = 0.f;
        if (pp >= LEADP) {
            const float ip = gates[(size_t)row * NGATE + h] + p.mbi[layer * 4 + h], fp = gates[(size_t)row * NGATE + 4 + h] + p.mbf[layer * 4 + h];
            li = 15.f * tanhf(ip * (1.f / 15.f)); lf = logsigmoidf_(15.f * tanhf(fp * (1.f / 15.f)));
        }
        const float cs = wave_scan_incl(lf, lane);
        const float last = __shfl(cs, 63);
        G[lane] = li; G[64 + lane] = cs;
        if (phaseA) {
            const float te = last - cs + li;
            const float ml = wave_max(te);
            G[128 + lane] = __expf(te - ml);
            if (lane == 0) { float* sc = (float*)(p.ws + WS_SC_M) + ((size_t)c * 4 + h) * 2; sc[0] = ml; sc[1] = last; }
        } else {
            const float mprev = ((const float*)(p.ws + WS_MP_M))[(size_t)c * 4 + h];
            const float mintra = cs + wave_scan_max_incl(li - cs, lane);
            const float inter = cs + mprev;
            const float mt = fmaxf(inter, mintra);
            G[128 + lane] = mt; G[192 + lane] = __expf(inter - mt); G[256 + lane] = __expf(-mt);
        }
    }
}

__device__ __forceinline__ void phase_a(const Params& p, int layer, LAS unsigned char* lds, int c, int h) {
    const int tid = opaque_tid(), lane = tid & 63, wave = __builtin_amdgcn_readfirstlane(tid >> 6), fr = lane & 15, fq = lane >> 4;
    LAS float* G = (LAS float*)(lds + OFF_G);
    const bf16_t* proj = (const bf16_t*)(p.ws + WS_PROJ) + (size_t)(c * 64) * NPROJ;
    const u32x4 kraw = *(const u32x4*)(proj + (size_t)(tid >> 3) * NPROJ + P_MK + h * 64 + (tid & 7) * 8);
    u32x4 vraw[2];
#pragma unroll
    for (int it = 0; it < 2; ++it) { const int item = it * 512 + tid; vraw[it] = *(const u32x4*)(proj + (size_t)(item >> 4) * NPROJ + P_MV + h * 128 + (item & 15) * 8); }
    gates(p, layer, lds, c, h, true);
    __syncthreads();
    {
        { const int s = tid >> 3, ch = tid & 7; float f[8]; unpack8(kraw, f); const float w = G[128 + s];
#pragma unroll
          for (int j = 0; j < 8; ++j) f[j] *= w;
          *(LAS u32x4*)(lds + OFF_K + s * PQ + ch * 16) = pack8(f); }
#pragma unroll
        for (int it = 0; it < 2; ++it) { const int item = it * 512 + tid; *(LAS u32x4*)(lds + OFF_V + (item >> 4) * PV + (item & 15) * 16) = vraw[it]; }
    }
    __syncthreads();
    bf16_t* st = (bf16_t*)(p.ws + WS_ST_M) + ((size_t)c * 4 + h) * 8192;
    {
        const int et = wave;
        bf16x8 vb[2];
#pragma unroll
        for (int ks = 0; ks < 2; ++ks) vb[ks] = frag_tr<PV>(lds + OFF_V, ks * 32, et * 16, lane);
#pragma unroll
        for (int dt = 0; dt < 4; ++dt) {
            f32x4 acc = (f32x4){0.f, 0.f, 0.f, 0.f};
#pragma unroll
            for (int ks = 0; ks < 2; ++ks) acc = mfma16(frag_tr<PQ>(lds + OFF_K, ks * 32, dt * 16, lane), vb[ks], acc);
            u32x2 o; o.x = cvt_pk_bf16(acc[0], acc[1]); o.y = cvt_pk_bf16(acc[2], acc[3]);
            *(u32x2*)(st + frag_off4<2>(et * 16 + fr, dt * 16 + 4 * fq)) = o;
        }
    }
    if (tid < 64) {
        float s = 0.f;
        for (int r = 0; r < 64; ++r) s += bf2f(*(LAS bf16_t*)(lds + OFF_K + r * PQ + tid * 2));
        ((float*)(p.ws + WS_NV_M))[((size_t)c * 4 + h) * 64 + tid] = s;
    }
    __syncthreads();
}

__device__ __forceinline__ void phase_c(const Params& p, int layer, LAS unsigned char* lds, int c, int h) {
    const int tid = opaque_tid(), lane = tid & 63, wave = __builtin_amdgcn_readfirstlane(tid >> 6), fr = lane & 15, fq = lane >> 4;
    LAS float* G = (LAS float*)(lds + OFF_G);
    const bf16_t* proj = (const bf16_t*)(p.ws + WS_PROJ) + (size_t)(c * 64) * NPROJ;
    const int ch = tid & 31, srow = tid >> 5;
    const int col = ch < 8 ? P_MQ + h * 64 + ch * 8 : (ch < 16 ? P_MK + h * 64 + (ch - 8) * 8 : P_MV + h * 128 + (ch - 16) * 8);
    u32x4 raw[4], og[2];
#pragma unroll
    for (int it = 0; it < 4; ++it) raw[it] = *(const u32x4*)(proj + (size_t)(it * 16 + srow) * NPROJ + col);
#pragma unroll
    for (int it = 0; it < 2; ++it) { const int item = it * 512 + tid; og[it] = *(const u32x4*)(proj + (size_t)(item >> 4) * NPROJ + P_MO + h * 128 + (item & 15) * 8); }
    const bf16_t* st = (const bf16_t*)(p.ws + WS_ST_M) + ((size_t)c * 4 + h) * 8192;
    bf16x8 cf[2];
#pragma unroll
    for (int ks = 0; ks < 2; ++ks) cf[ks] = *(const bf16x8*)(st + ((wave * 2 + ks) * 64 + lane) * 8);
    float npv = 0.f; if (tid < 64) npv = ((const float*)(p.ws + WS_NV_M))[((size_t)c * 4 + h) * 64 + tid];
    gates(p, layer, lds, c, h, false);
    {
        if (tid < 64) G[320 + tid] = npv;
        const int loff = ch < 8 ? OFF_Q + ch * 16 : (ch < 16 ? OFF_K + (ch - 8) * 16 : OFF_V + (ch - 16) * 16), pitch = ch < 16 ? PQ : PV;
#pragma unroll
        for (int it = 0; it < 4; ++it) { u32x4 w = raw[it];
            if (ch < 8) { float f[8]; unpack8(w, f);
#pragma unroll
                for (int j = 0; j < 8; ++j) f[j] *= 0.125f;
                w = pack8(f); }
            *(LAS u32x4*)(lds + loff + (it * 16 + srow) * pitch) = w; }
        if (tid < 128) { u32x4 o; o.x = (tid & 1) ? 0u : 0x00003f80u; o.y = 0u; o.z = 0u; o.w = 0u; *(LAS u32x4*)(lds + OFF_V + (tid >> 1) * PV + 256 + (tid & 1) * 16) = o; }
    }
    __syncthreads();
    for (int ti = wave; ti < 12; ti += 8) {
        int tt, st; bool zero = false;
        if (ti < 10) { tt = ti < 1 ? 0 : ti < 3 ? 1 : ti < 6 ? 2 : 3; st = ti - (tt * (tt + 1)) / 2; }
        else { zero = true; tt = ti == 10 ? 0 : 2; st = tt + 1; }
        f32x4 acc = (f32x4){0.f, 0.f, 0.f, 0.f};
        if (!zero) {
#pragma unroll
            for (int ks = 0; ks < 2; ++ks) acc = mfma16(frag_row<PQ>(lds + OFF_Q, tt * 16, ks * 32, fr, fq), frag_row<PQ>(lds + OFF_K, st * 16, ks * 32, fr, fq), acc);
        }
        const int s = st * 16 + fr, t0 = tt * 16 + 4 * fq;
        const float gs = G[s] - G[64 + s];
        const f32x4 ct4 = *(const LAS f32x4*)(G + 64 + t0), mt4 = *(const LAS f32x4*)(G + 128 + t0);
#pragma unroll
        for (int r = 0; r < 4; ++r) {
            const int t = t0 + r;
            float v = acc[r] * __expf(ct4[r] + gs - mt4[r]);
            v = (!zero && s <= t) ? v : 0.f;
            *(LAS bf16_t*)(lds + OFF_P + t * PP + s * 2) = f2bf(v);
        }
    }
    __syncthreads();
    f32x4 y[4], yd = (f32x4){0.f, 0.f, 0.f, 0.f};
    {
        bf16x8 vf[2];
#pragma unroll
        for (int ks = 0; ks < 2; ++ks) vf[ks] = frag_tr<PV>(lds + OFF_V, ks * 32, wave * 16, lane);
#pragma unroll
        for (int tt = 0; tt < 4; ++tt) {
            f32x4 acc = (f32x4){0.f, 0.f, 0.f, 0.f};
#pragma unroll
            for (int ks = 0; ks < 2; ++ks) acc = mfma16(frag_row<PQ>(lds + OFF_Q, tt * 16, ks * 32, fr, fq), cf[ks], acc);
#pragma unroll
            for (int r = 0; r < 4; ++r) acc[r] *= G[192 + tt * 16 + 4 * fq + r];
            acc = mfma16(frag_row<PP>(lds + OFF_P, tt * 16, 0, fr, fq), vf[0], acc);
            if (tt >= 2) acc = mfma16(frag_row<PP>(lds + OFF_P, tt * 16, 32, fr, fq), vf[1], acc);
            y[tt] = acc;
        }
        if (wave < 4) {
            const int tt = wave;
            bf16x8 nf[2], of[2];
#pragma unroll
            for (int ks = 0; ks < 2; ++ks) {
                float f[8];
#pragma unroll
                for (int j = 0; j < 8; ++j) f[j] = (fr == 0) ? G[320 + ks * 32 + 8 * fq + j] : 0.f;
                const u32x4 w = pack8(f); nf[ks] = __builtin_bit_cast(bf16x8, w);
                of[ks] = frag_tr<PV>(lds + OFF_V, ks * 32, 128, lane);
            }
            f32x4 acc = (f32x4){0.f, 0.f, 0.f, 0.f};
#pragma unroll
            for (int ks = 0; ks < 2; ++ks) acc = mfma16(frag_row<PQ>(lds + OFF_Q, tt * 16, ks * 32, fr, fq), nf[ks], acc);
#pragma unroll
            for (int r = 0; r < 4; ++r) acc[r] *= G[192 + tt * 16 + 4 * fq + r];
            acc = mfma16(frag_row<PP>(lds + OFF_P, tt * 16, 0, fr, fq), of[0], acc);
            if (tt >= 2) acc = mfma16(frag_row<PP>(lds + OFF_P, tt * 16, 32, fr, fq), of[1], acc);
            yd = acc;
        }
    }
    LAS float* Y = (LAS float*)(lds + OFF_Y);
#pragma unroll
    for (int tt = 0; tt < 4; ++tt)
#pragma unroll
        for (int r = 0; r < 4; ++r) Y[(tt * 16 + 4 * fq + r) * PY + wave * 16 + fr] = y[tt][r];
    if (wave < 4) {
#pragma unroll
        for (int r = 0; r < 4; ++r) Y[(wave * 16 + 4 * fq + r) * PY + 128 + fr] = yd[r];
    }
    __syncthreads();
    bf16_t* mixed = (bf16_t*)(p.ws + WS_MIXED);
    const float* nw = p.mlnw + (size_t)layer * 512 + h * 128;
#pragma unroll
    for (int it = 0; it < 2; ++it) {
        const int item = it * 512 + tid, rloc = item >> 4, cgp = item & 15, row = c * 64 + rloc;
        const float den = Y[rloc * PY + 128];
        const float inv = 1.f / fmaxf(fabsf(den), G[256 + rloc]);
        float o[8], v[8];
        unpack8(og[it], o);
        float ss = 0.f;
#pragma unroll
        for (int j = 0; j < 8; ++j) { v[j] = Y[rloc * PY + cgp * 8 + j] * inv; ss += v[j] * v[j]; }
        ss = sum16_dpp(ss);
        const float rs = rsqrtf(ss * (1.f / 128.f) + EPS);
        const f32x4 w0 = *(const f32x4*)(nw + cgp * 8), w1 = *(const f32x4*)(nw + cgp * 8 + 4);
        const float wv[8] = {w0.x, w0.y, w0.z, w0.w, w1.x, w1.y, w1.z, w1.w};
#pragma unroll
        for (int j = 0; j < 8; ++j) v[j] *= rs * wv[j] * sigmoidf_(o[j]);
        *(u32x4*)(mixed + (size_t)row * D + 512 + h * 128 + cgp * 8) = pack8(v);
    }
    __syncthreads();
}

__device__ __forceinline__ void scan_item(const Params& p, int item) {
    const int bh = __builtin_amdgcn_readfirstlane(item / 1088), sub = item - bh * 1088, b = bh >> 2, h = bh & 3;
    const float* sc = (const float*)(p.ws + WS_SC_M) + ((size_t)(b * CPB) * 4 + h) * 2;
    float m_ = 0.f;
    if (sub < 1024) {
        bf16_t* base = (bf16_t*)(p.ws + WS_ST_M) + ((size_t)(b * CPB) * 4 + h) * 8192 + sub * 8;
        u32x4 loc[CPB];
#pragma unroll
        for (int n = 0; n < CPB; ++n) loc[n] = SCAN_LD((const u32x4*)(base + (size_t)n * 4 * 8192));
        float S[8];
#pragma unroll
        for (int j = 0; j < 8; ++j) S[j] = 0.f;
#pragma unroll
        for (int n = 0; n < CPB; ++n) {
            const float ml = sc[n * 8], tot = sc[n * 8 + 1];
            const float mn = fmaxf(tot + m_, ml), a_ = __expf(tot + m_ - mn), s_ = __expf(ml - mn);
            float l[8]; unpack8(loc[n], l);
            *(u32x4*)(base + (size_t)n * 4 * 8192) = pack8(S);
#pragma unroll
            for (int j = 0; j < 8; ++j) S[j] = a_ * S[j] + s_ * l[j];
            m_ = mn;
        }
    } else {
        const int d = sub - 1024;
        float* nv = (float*)(p.ws + WS_NV_M) + ((size_t)(b * CPB) * 4 + h) * 64 + d;
        float* mp = (float*)(p.ws + WS_MP_M) + (size_t)(b * CPB) * 4 + h;
        float loc[CPB];
#pragma unroll
        for (int n = 0; n < CPB; ++n) loc[n] = nv[(size_t)n * 4 * 64];
        float S = 0.f;
#pragma unroll
        for (int n = 0; n < CPB; ++n) {
            const float ml = sc[n * 8], tot = sc[n * 8 + 1];
            const float mn = fmaxf(tot + m_, ml), a_ = __expf(tot + m_ - mn), s_ = __expf(ml - mn);
            nv[(size_t)n * 4 * 64] = S; S = a_ * S + s_ * loc[n];
            if (d == 0) mp[n * 4] = m_;
            m_ = mn;
        }
    }
}
}
namespace hgr {
constexpr int PF = 132;
constexpr int PT = 272;
constexpr int PP = 144;
constexpr int OFF_X = 0, X_BYTES = 2 * 64 * PT, OFF_CUM = OFF_X + X_BYTES, OFF_KS = OFF_CUM + 64 * PF * 4, OFF_V = OFF_KS + 10 * 16 * PT, OFF_P = OFF_V + 64 * PT, OFF_END = OFF_P + 64 * PP;
static_assert(64 * PF * 4 <= X_BYTES, "LF fits region X");
static_assert(OFF_END <= 147456 - 64, "hgrn2 LDS");
constexpr int OFF_QS = OFF_X, OFF_QC = OFF_X + 64 * PT;

__device__ __forceinline__ float lb_of(const Params& p, int layer, int ch) {
    if (layer == 0) return 0.f;
    const float a0 = p.lbl[ch], a1 = p.lbl[512 + ch];
    return __builtin_amdgcn_rcpf(1.f + __expf(a0 - a1));
}
__device__ __forceinline__ void gates(const Params& p, int layer, LAS unsigned char* lds, int c, int h, const u32x4 (&fraw)[2]) {
    const int tid = opaque_tid();
    LAS float* LF = (LAS float*)(lds + OFF_X); LAS float* CUM = (LAS float*)(lds + OFF_CUM);
#pragma unroll
    for (int it = 0; it < 2; ++it) {
        const int item = it * 512 + tid, s = item >> 4, cg = item & 15;
        const int pp = (c * 64 + s) % PB;
        float z[8], lf[8];
        unpack8(fraw[it], z);
#pragma unroll
        for (int j = 0; j < 8; ++j) {
            const float lb = lb_of(p, layer, h * 128 + cg * 8 + j);
            const float f = lb + (1.f - lb) * sigmoidf_(z[j]);
            lf[j] = pp >= LEADP ? __logf(f) : 0.f;
        }
        *(LAS f32x4*)(LF + s * PF + cg * 8) = (f32x4){lf[0], lf[1], lf[2], lf[3]};
        *(LAS f32x4*)(LF + s * PF + cg * 8 + 4) = (f32x4){lf[4], lf[5], lf[6], lf[7]};
    }
    __syncthreads();
    {
        const int d = tid & 127, sb = tid >> 7;
        float run = 0.f;
#pragma unroll
        for (int i = 0; i < 16; ++i) { run += LF[(sb * 16 + i) * PF + d]; CUM[(sb * 16 + i) * PF + d] = run; }
    }
    __syncthreads();
    {
        const int d = tid & 127, sb = tid >> 7;
        float pre = 0.f;
        for (int q = 0; q < sb; ++q) pre += CUM[(q * 16 + 15) * PF + d];
        __syncthreads();
#pragma unroll
        for (int i = 0; i < 16; ++i) { const int s = sb * 16 + i; CUM[s * PF + d] += pre; const int pp = (c * 64 + s) % PB; LF[s * PF + d] = pp >= LEADP ? 1.f - __expf(LF[s * PF + d]) : 0.f; }
    }
    __syncthreads();
}
__device__ __forceinline__ void load_rows(const Params& p, int c, int col, u32x4 (&raw)[2]) {
    const int tid = opaque_tid();
    const bf16_t* proj = (const bf16_t*)(p.ws + WS_PROJ) + (size_t)(c * 64) * NPROJ + col;
#pragma unroll
    for (int it = 0; it < 2; ++it) { const int item = it * 512 + tid; raw[it] = *(const u32x4*)(proj + (size_t)(item >> 4) * NPROJ + (item & 15) * 8); }
}
__device__ __forceinline__ void stage_v(LAS unsigned char* lds, const u32x4 (&vraw)[2]) {
    const int tid = opaque_tid();
#pragma unroll
    for (int it = 0; it < 2; ++it) { const int item = it * 512 + tid, s = item >> 4, cg = item & 15;
        *(LAS u32x4*)(lds + OFF_V + s * PT + cg * 16) = vraw[it]; }
}

__device__ __forceinline__ void phase_a(const Params& p, int layer, LAS unsigned char* lds, int c, int h) {
    const int tid = opaque_tid(), lane = tid & 63, wave = __builtin_amdgcn_readfirstlane(tid >> 6), fr = lane & 15, fq = lane >> 4;
    LAS float* KF = (LAS float*)(lds + OFF_X); LAS float* CUM = (LAS float*)(lds + OFF_CUM);
    u32x4 vraw[2], fraw[2];
    load_rows(p, c, P_HI + h * 128, vraw); load_rows(p, c, P_HF + h * 128, fraw);
    stage_v(lds, vraw);
    gates(p, layer, lds, c, h, fraw);
#pragma unroll
    for (int it = 0; it < 2; ++it) {
        const int item = it * 512 + tid, s = item >> 4, cg = item & 15;
        float o[8];
#pragma unroll
        for (int hh = 0; hh < 2; ++hh) { const int d = cg * 8 + 4 * hh;
            const f32x4 kf = *(const LAS f32x4*)(KF + s * PF + d), cl = *(const LAS f32x4*)(CUM + 63 * PF + d), cs = *(const LAS f32x4*)(CUM + s * PF + d);
            o[4 * hh + 0] = kf.x * __expf(cl.x - cs.x); o[4 * hh + 1] = kf.y * __expf(cl.y - cs.y); o[4 * hh + 2] = kf.z * __expf(cl.z - cs.z); o[4 * hh + 3] = kf.w * __expf(cl.w - cs.w); }
        *(LAS u32x4*)(lds + OFF_KS + s * PT + cg * 16) = pack8(o);
    }
    if (tid < 128) ((float*)(p.ws + WS_DEC_H))[((size_t)c * 4 + h) * 128 + tid] = __expf(CUM[63 * PF + tid]);
    __syncthreads();
    bf16_t* st = (bf16_t*)(p.ws + WS_ST_H) + ((size_t)c * 4 + h) * 16384;
    {
        const int et = wave;
        bf16x8 vb[2];
#pragma unroll
        for (int ks = 0; ks < 2; ++ks) vb[ks] = frag_tr<PT>(lds + OFF_V, ks * 32, et * 16, lane);
#pragma unroll
        for (int dt = 0; dt < 8; ++dt) {
            f32x4 acc = (f32x4){0.f, 0.f, 0.f, 0.f};
#pragma unroll
            for (int ks = 0; ks < 2; ++ks) acc = mfma16(frag_tr<PT>(lds + OFF_KS, ks * 32, dt * 16, lane), vb[ks], acc);
            u32x2 o; o.x = cvt_pk_bf16(acc[0], acc[1]); o.y = cvt_pk_bf16(acc[2], acc[3]);
            *(u32x2*)(st + frag_off4<4>(et * 16 + fr, dt * 16 + 4 * fq)) = o;
        }
    }
    __syncthreads();
}

__device__ __forceinline__ void phase_c(const Params& p, int layer, LAS unsigned char* lds, int c, int h) {
    const int tid = opaque_tid(), lane = tid & 63, wave = __builtin_amdgcn_readfirstlane(tid >> 6), fr = lane & 15, fq = lane >> 4;
    LAS float* KF = (LAS float*)(lds + OFF_X); LAS float* CUM = (LAS float*)(lds + OFF_CUM);
    u32x4 vraw[2], fraw[2], qraw[2], graw[2];
    load_rows(p, c, P_HI + h * 128, vraw); load_rows(p, c, P_HF + h * 128, fraw); load_rows(p, c, P_HQ + h * 128, qraw); load_rows(p, c, P_HG + h * 128, graw);
    const bf16_t* st = (const bf16_t*)(p.ws + WS_ST_H) + ((size_t)c * 4 + h) * 16384;
    bf16x8 sf[4];
#pragma unroll
    for (int ks = 0; ks < 4; ++ks) sf[ks] = *(const bf16x8*)(st + ((wave * 4 + ks) * 64 + lane) * 8);
    stage_v(lds, vraw);
    gates(p, layer, lds, c, h, fraw);
    for (int item = tid; item < 10 * 16 * 16; item += NTHREADS) {
        const int sbi = item >> 8, rs = (item >> 4) & 15, cg = item & 15;
        const int j = sbi < 1 ? 0 : sbi < 3 ? 1 : sbi < 6 ? 2 : 3, i = sbi - (j * (j + 1)) / 2, s = i * 16 + rs;
        float o[8];
#pragma unroll
        for (int hh = 0; hh < 2; ++hh) { const int d = cg * 8 + 4 * hh;
            const f32x4 kf = *(const LAS f32x4*)(KF + s * PF + d), cs = *(const LAS f32x4*)(CUM + s * PF + d);
            f32x4 rf = (f32x4){0.f, 0.f, 0.f, 0.f}; if (j > 0) rf = *(const LAS f32x4*)(CUM + (16 * j - 1) * PF + d);
            o[4 * hh + 0] = kf.x * __expf(rf.x - cs.x); o[4 * hh + 1] = kf.y * __expf(rf.y - cs.y); o[4 * hh + 2] = kf.z * __expf(rf.z - cs.z); o[4 * hh + 3] = kf.w * __expf(rf.w - cs.w); }
        *(LAS u32x4*)(lds + OFF_KS + (sbi * 16 + rs) * PT + cg * 16) = pack8(o);
    }
    __syncthreads();
#pragma unroll
    for (int it = 0; it < 2; ++it) {
        const int item = it * 512 + tid, t = item >> 4, cg = item & 15, j = t >> 4;
        float q[8], a[8], b[8];
        unpack8(qraw[it], q);
#pragma unroll
        for (int hh = 0; hh < 2; ++hh) { const int d = cg * 8 + 4 * hh;
            const f32x4 cu = *(const LAS f32x4*)(CUM + t * PF + d);
            f32x4 rf = (f32x4){0.f, 0.f, 0.f, 0.f}; if (j > 0) rf = *(const LAS f32x4*)(CUM + (16 * j - 1) * PF + d);
            const float cuv[4] = {cu.x, cu.y, cu.z, cu.w}, rfv[4] = {rf.x, rf.y, rf.z, rf.w};
#pragma unroll
            for (int k = 0; k < 4; ++k) { const float qq = q[4 * hh + k] * 0.08838834764831845f; a[4 * hh + k] = qq * __expf(cuv[k] - rfv[k]); b[4 * hh + k] = qq * __expf(cuv[k]); } }
        *(LAS u32x4*)(lds + OFF_QS + t * PT + cg * 16) = pack8(a);
        *(LAS u32x4*)(lds + OFF_QC + t * PT + cg * 16) = pack8(b);
    }
    __syncthreads();
    for (int ti = wave; ti < 12; ti += 8) {
        int tt, st; bool zero = false;
        if (ti < 10) { tt = ti < 1 ? 0 : ti < 3 ? 1 : ti < 6 ? 2 : 3; st = ti - (tt * (tt + 1)) / 2; }
        else { zero = true; tt = ti == 10 ? 0 : 2; st = tt + 1; }
        f32x4 acc = (f32x4){0.f, 0.f, 0.f, 0.f};
        if (!zero) {
#pragma unroll
            for (int ks = 0; ks < 4; ++ks) acc = mfma16(frag_row<PT>(lds + OFF_QS, tt * 16, ks * 32, fr, fq), frag_row<PT>(lds + OFF_KS + ti * 16 * PT, 0, ks * 32, fr, fq), acc);
        }
        const int s = st * 16 + fr;
#pragma unroll
        for (int r = 0; r < 4; ++r) {
            const int t = tt * 16 + 4 * fq + r;
            const float v = (!zero && s <= t) ? acc[r] : 0.f;
            *(LAS bf16_t*)(lds + OFF_P + t * PP + s * 2) = f2bf(v);
        }
    }
    __syncthreads();
    f32x4 y[4];
    {
        bf16x8 vf[2];
#pragma unroll
        for (int ks = 0; ks < 2; ++ks) vf[ks] = frag_tr<PT>(lds + OFF_V, ks * 32, wave * 16, lane);
#pragma unroll
        for (int tt = 0; tt < 4; ++tt) {
            f32x4 acc = (f32x4){0.f, 0.f, 0.f, 0.f};
#pragma unroll
            for (int ks = 0; ks < 4; ++ks) acc = mfma16(frag_row<PT>(lds + OFF_QC, tt * 16, ks * 32, fr, fq), sf[ks], acc);
            acc = mfma16(frag_row<PP>(lds + OFF_P, tt * 16, 0, fr, fq), vf[0], acc);
            if (tt >= 2) acc = mfma16(frag_row<PP>(lds + OFF_P, tt * 16, 32, fr, fq), vf[1], acc);
            y[tt] = acc;
        }
    }
    LAS float* Y = (LAS float*)(lds + OFF_CUM);
#pragma unroll
    for (int tt = 0; tt < 4; ++tt)
#pragma unroll
        for (int r = 0; r < 4; ++r) Y[(tt * 16 + 4 * fq + r) * PF + wave * 16 + fr] = y[tt][r];
    __syncthreads();
    bf16_t* mixed = (bf16_t*)(p.ws + WS_MIXED);
    const float* nw = p.hgnw + (size_t)layer * 512 + h * 128;
#pragma unroll
    for (int it = 0; it < 2; ++it) {
        const int item = it * 512 + tid, rloc = item >> 4, cgp = item & 15, row = c * 64 + rloc;
        float g[8], v[8];
        unpack8(graw[it], g);
        float ss = 0.f;
#pragma unroll
        for (int j = 0; j < 8; ++j) { v[j] = Y[rloc * PF + cgp * 8 + j]; ss += v[j] * v[j]; }
        ss = sum16_dpp(ss);
        const float rs = rsqrtf(ss * (1.f / 128.f) + EPS);
        const f32x4 w0 = *(const f32x4*)(nw + cgp * 8), w1 = *(const f32x4*)(nw + cgp * 8 + 4);
        const float wv[8] = {w0.x, w0.y, w0.z, w0.w, w1.x, w1.y, w1.z, w1.w};
#pragma unroll
        for (int j = 0; j < 8; ++j) v[j] *= rs * wv[j] * siluf_(g[j]);
        *(u32x4*)(mixed + (size_t)row * D + h * 128 + cgp * 8) = pack8(v);
    }
    __syncthreads();
}

__device__ __forceinline__ void scan_item(const Params& p, int item) {
    const int e8 = item & 2047, bh = __builtin_amdgcn_readfirstlane(item >> 11), b = bh >> 2, h = bh & 3;
    const int ks = (e8 >> 6) & 3, fql = (e8 & 63) >> 4, d0 = ks * 32 + 8 * fql;
    bf16_t* base = (bf16_t*)(p.ws + WS_ST_H) + ((size_t)(b * CPB) * 4 + h) * 16384 + e8 * 8;
    const float* dec = (const float*)(p.ws + WS_DEC_H) + ((size_t)(b * CPB) * 4 + h) * 128 + d0;
    float S[8];
#pragma unroll
    for (int j = 0; j < 8; ++j) S[j] = 0.f;
#pragma unroll 1
    for (int g = 0; g < 3; ++g) {
        u32x4 loc[11]; f32x4 da[11], db[11];
#pragma unroll
        for (int i = 0; i < 11; ++i) { const int n = g * 11 + i; loc[i] = SCAN_LD((const u32x4*)(base + (size_t)n * 4 * 16384)); da[i] = *(const f32x4*)(dec + (size_t)n * 4 * 128); db[i] = *(const f32x4*)(dec + (size_t)n * 4 * 128 + 4); }
#pragma unroll
        for (int i = 0; i < 11; ++i) { const int n = g * 11 + i;
            const float dd[8] = {da[i].x, da[i].y, da[i].z, da[i].w, db[i].x, db[i].y, db[i].z, db[i].w};
            float l[8]; unpack8(loc[i], l);
            *(u32x4*)(base + (size_t)n * 4 * 16384) = pack8(S);
#pragma unroll
            for (int j = 0; j < 8; ++j) S[j] = dd[j] * S[j] + l[j]; }
    }
}
}
#ifndef NEW_H
#define NEW_H 1
#endif
#ifndef NEW_M
#define NEW_M 1
#endif
#ifndef NEW_S
#define NEW_S 1
#endif
#ifndef MIXRPT_SC
#define MIXRPT_SC 1
#endif
#ifndef MIXRPT_MC
#define MIXRPT_MC 1
#endif
#ifndef MIXRPT_HC
#define MIXRPT_HC 1
#endif
#ifndef MIXRPT_SA
#define MIXRPT_SA 1
#endif
#ifndef MIXRPT_MA
#define MIXRPT_MA 1
#endif
#ifndef MIXRPT_HA
#define MIXRPT_HA 1
#endif
template <bool PHASE_C>
__device__ __forceinline__ void phase_mix(const Params& p, int layer, LAS unsigned char* lds) {
    for (int u = blockIdx.x; u < 3 * NCH * 4; u += gridDim.x) {
        const int type = u % 3, idx = u / 3, c = idx >> 2, sub = idx & 3;
        if (type == 0) { for (int rp = 0; rp < (PHASE_C ? MIXRPT_SC : MIXRPT_SA); ++rp) { if (PHASE_C) ssd::phase_c(p, layer, lds, c, sub); else ssd::phase_a(p, layer, lds, c, sub); } }
        else if (type == 1) { for (int rp = 0; rp < (PHASE_C ? MIXRPT_MC : MIXRPT_MA); ++rp) { if (PHASE_C) mls::phase_c(p, layer, lds, c, sub); else mls::phase_a(p, layer, lds, c, sub); } }
        else { for (int rp = 0; rp < (PHASE_C ? MIXRPT_HC : MIXRPT_HA); ++rp) { if (PHASE_C) hgr::phase_c(p, layer, lds, c, sub); else hgr::phase_a(p, layer, lds, c, sub); } }
    }
}
__device__ __forceinline__ void phase_scan(const Params& p) {
    constexpr int N_S = NB * 16 * 1024, N_M = NB * 4 * 1088, N_H = NB * 4 * 2048;
    for (int gid = blockIdx.x * NTHREADS + opaque_tid(); gid < N_S + N_M + N_H; gid += gridDim.x * NTHREADS) {
        if (gid < N_S) { if (NEW_S) ssd::scan_item(p, gid); }
        else if (gid < N_S + N_M) { if (NEW_M) mls::scan_item(p, gid - N_S); }
        else { if (NEW_H) hgr::scan_item(p, gid - N_S - N_M); }
    }
}
struct EpiResid {
    static constexpr bool PERM = false;
    const float* base; float* out; int ldc;
    __device__ __forceinline__ void operator()(const f32x4 (&acc)[2][2][4][2], const pg8::GU& u, int wr, int wc, int fr, int fq) const {
        const int row0 = u.r0 + wr * 64 + fr, col0 = u.c0 + wc * 32 + 4 * fq;
#pragma unroll
        for (int ai = 0; ai < 2; ++ai) if (ai == 0 || !u.half)
#pragma unroll
            for (int m = 0; m < 4; ++m) { const size_t ro = (size_t)(row0 + ai * 128 + m * 16) * ldc + col0;
#pragma unroll
                for (int bj = 0; bj < 2; ++bj)
#pragma unroll
                    for (int n = 0; n < 2; ++n) { const f32x4 b = *(const f32x4*)(base + ro + bj * 128 + n * 16); { const f32x4 o_ = acc[ai][bj][m][n] + b; NT_STORE(o_, (f32x4*)(out + ro + bj * 128 + n * 16)); } } }
    }
};
struct SchedG2 {
    static constexpr int ldb = D * 2;
    pg8::TileOrder T; const char* A; const char* W;
    __device__ bool next(int i, pg8::GU& u) const { int pm, pn; if (!T.tile(i, pm, pn)) return false;
        u.a = A + (size_t)pm * 256 * D * 2; u.b0 = W + (size_t)pn * 256 * 2; u.b1 = u.b0 + 256; u.r0 = pm * 256; u.c0 = pn * 256; u.ex = 0; u.half = 0; return true; }
    __device__ int row(const pg8::GU&, int) const { return 0; }
};
struct EpiResid0 {
    static constexpr bool PERM = false;
    const float* x; const float* meta; float* out;
    __device__ __forceinline__ void operator()(const f32x4 (&acc)[2][2][4][2], const pg8::GU& u, int wr, int wc, int fr, int fq) const {
        const int row0 = u.r0 + wr * 64 + fr, col0 = u.c0 + wc * 32 + 4 * fq;
#pragma unroll
        for (int ai = 0; ai < 2; ++ai) if (ai == 0 || !u.half)
#pragma unroll
            for (int m = 0; m < 4; ++m) { const int r = row0 + ai * 128 + m * 16, b = r / PB, pp = r % PB, l = pp - LEADP;
                const float* src = l < 0 ? nullptr : (l < NMETA ? meta + (size_t)l * D : x + ((size_t)b * SEQ + (l - NMETA)) * D);
                const size_t ro = (size_t)r * D + col0;
#pragma unroll
                for (int bj = 0; bj < 2; ++bj)
#pragma unroll
                    for (int n = 0; n < 2; ++n) { f32x4 bsv = (f32x4){0.f, 0.f, 0.f, 0.f}; if (src) bsv = *(const f32x4*)(src + col0 + bj * 128 + n * 16);
                        *(f32x4*)(out + ro + bj * 128 + n * 16) = acc[ai][bj][m][n] + bsv; } }
    }
};
__device__ __forceinline__ void phase_g2(const Params& p, int layer, LAS unsigned char* lds) {
    SchedG2 S; S.T.init(R / 256, D / 256, gridDim.x, blockIdx.x); S.A = (const char*)(p.ws + WS_MIXED); S.W = (const char*)(p.ws + WS_WTOUT) + (size_t)layer * D * D * 2;
    if (layer == 0) { EpiResid0 E{p.x, p.meta, (float*)(p.ws + WS_H1)}; pg8::gemm_phase<EpiResid0, SchedG2, false, 1>(lds, D, S, E); }
    else { EpiResid E{(const float*)(p.ws + WS_H0), (float*)(p.ws + WS_H1), D}; pg8::gemm_phase<EpiResid, SchedG2, false, 1>(lds, D, S, E); }
}
constexpr int RTOK = NB * LTOK;
constexpr int RPADMAX = 2 * RTOK + NE * 255;
constexpr size_t WS_W1T  = WS_MIX_END;
constexpr size_t WS_W3T  = WS_W1T + al256((size_t)DEPTH * NE * DE * D * 2);
constexpr size_t WS_W2T  = WS_W3T + al256((size_t)DEPTH * NE * DE * D * 2);
constexpr size_t WS_LIST = WS_W2T + al256((size_t)DEPTH * NE * D * DE * 2);
constexpr size_t WS_ROUTE = WS_LIST + al256((size_t)NE * RTOK * 4);
constexpr size_t WS_END  = WS_ROUTE + al256((size_t)R * 32);
constexpr size_t WS_HB = WS_MIXED;
constexpr size_t WS_YB = WS_PROJ;
static_assert((size_t)RPADMAX * DE * 2 <= WS_W1T - WS_MIXED, "H overlay");
static_assert((size_t)RPADMAX * D * 2 <= WS_GATES - WS_PROJ, "Y overlay");
#ifndef MOE_FP32
#define MOE_FP32 0
#endif
constexpr int MOE_TILE = MOE_FP32 ? 128 : 256;
constexpr int LDS_TAB = 131072;
struct Route { int e[2]; float w[2]; int slot[2]; int pad[2]; };

constexpr int CNT_STRIDE = 64;
__device__ __forceinline__ int* moe_cnt(const Params& p, int layer) { return (int*)(p.ws + WS_CTL) + CW_CNT + layer * 32 * CNT_STRIDE; }

__device__ __forceinline__ void phase_n2(const Params& p, int layer, LAS unsigned char* lds) {
    const int tid = opaque_tid(), lane = tid & 63, wave = __builtin_amdgcn_readfirstlane(tid >> 6), fr = lane & 15, fq = lane >> 4;
    static_assert(RTOK % 16 == 0, "16-token tiles");
    constexpr int NT = RTOK / 16;
    const float* h1 = (const float*)(p.ws + WS_H1); bf16_t* U = (bf16_t*)(p.ws + WS_U);
    const bf16_t* wrf = (const bf16_t*)(p.ws + WS_WRT) + (size_t)layer * WRF_LAYER + (size_t)lane * 8;
    const int half = wave >> 2, kq = wave & 3;
    LAS float* PART = (LAS float*)lds;
    LAS float* LG = (LAS float*)(lds + 32768) + half * (16 * 48 + 16);
#pragma unroll 1
    for (int pass = 0; pass * 2 * (int)gridDim.x < NT; ++pass) {
        const int tile = (int)blockIdx.x + (int)gridDim.x * (2 * pass + half);
        const bool act = tile < NT;
        const int tl = act ? tile : 0;
        const int t = tl * 16 + fr, rowA = (t / LTOK) * PB + LEADP + (t % LTOK);
        const float* ap = h1 + (size_t)rowA * D + kq * 512 + 8 * fq;
        f32x4 acc[3];
#pragma unroll
        for (int ct = 0; ct < 3; ++ct) acc[ct] = (f32x4){0.f, 0.f, 0.f, 0.f};
        float ss = 0.f;
        if (act) {
#pragma unroll 4
            for (int k = 0; k < 16; ++k) {
                const int ks = kq * 16 + k;
                const f32x4 c0 = *(const f32x4*)(ap + k * 32), c1 = *(const f32x4*)(ap + k * 32 + 4);
                bf16x8 bh[3], bl[3];
#pragma unroll
                for (int ct = 0; ct < 3; ++ct) { bh[ct] = *(const bf16x8*)(wrf + ((size_t)(ks * 3 + ct) * 2) * 512); bl[ct] = *(const bf16x8*)(wrf + ((size_t)(ks * 3 + ct) * 2 + 1) * 512); }
                const float xv[8] = {c0.x, c0.y, c0.z, c0.w, c1.x, c1.y, c1.z, c1.w};
                float hi[8], lo[8];
#pragma unroll
                for (int j = 0; j < 8; ++j) { ss += xv[j] * xv[j]; hi[j] = bf2f(f2bf(xv[j])); lo[j] = xv[j] - hi[j]; }
                const u32x4 ph = pack8(hi), pl = pack8(lo);
                const bf16x8 ah = __builtin_bit_cast(bf16x8, ph), al = __builtin_bit_cast(bf16x8, pl);
#pragma unroll
                for (int ct = 0; ct < 3; ++ct) { acc[ct] = mfma16(ah, bh[ct], acc[ct]); acc[ct] = mfma16(ah, bl[ct], acc[ct]); acc[ct] = mfma16(al, bh[ct], acc[ct]); }
            }
        }
#pragma unroll
        for (int ct = 0; ct < 3; ++ct)
#pragma unroll
            for (int r = 0; r < 4; ++r) PART[(wave * 13 + ct * 4 + r) * 64 + lane] = acc[ct][r];
        PART[(wave * 13 + 12) * 64 + lane] = ss;
        __syncthreads();
        if (kq == 0) {
            float tot[13];
#pragma unroll
            for (int i = 0; i < 13; ++i) tot[i] = PART[((wave + 0) * 13 + i) * 64 + lane] + PART[((wave + 1) * 13 + i) * 64 + lane] + PART[((wave + 2) * 13 + i) * 64 + lane] + PART[((wave + 3) * 13 + i) * 64 + lane];
            float sq = tot[12]; sq += __shfl_xor(sq, 16); sq += __shfl_xor(sq, 32);
            const float rs = rsqrtf(sq * (1.f / D) + EPS);
#pragma unroll
            for (int ct = 0; ct < 3; ++ct)
#pragma unroll
                for (int r = 0; r < 4; ++r) LG[(4 * fq + r) * 48 + ct * 16 + fr] = tot[ct * 4 + r];
            if (fq == 0) LG[16 * 48 + fr] = rs;
            LDS_WAIT(); asm volatile("" ::: "memory");
            if (act && lane < 16) {
                const LAS float* lg = LG + lane * 48;
                float l[4];
#pragma unroll
                for (int g = 0; g < 4; ++g) l[g] = lg[g] * rs + p.bg[layer * 4 + g];
                int gs = 0; float gm = l[0];
#pragma unroll
                for (int g = 1; g < 4; ++g) if (l[g] > gm) { gm = l[g]; gs = g; }
                float den = 0.f;
#pragma unroll
                for (int g = 0; g < 4; ++g) den += __expf(l[g] - gm);
                const float ggate = 1.f / den;
                float v0 = -3.0e38f, v1 = -3.0e38f; int i0 = 0, i1 = 0;
#pragma unroll
                for (int e = 0; e < 8; ++e) { const float x = lg[4 + gs * 8 + e] * rs + p.br[layer * 32 + gs * 8 + e];
                    if (x > v0) { v1 = v0; i1 = i0; v0 = x; i0 = e; } else if (x > v1) { v1 = x; i1 = e; } }
                int* cnt = moe_cnt(p, layer); int* list = (int*)(p.ws + WS_LIST); Route* route = (Route*)(p.ws + WS_ROUTE);
                const float p1 = __expf(v1 - v0), sden = 1.f + p1;
                Route rt; rt.e[0] = gs * 8 + i0; rt.e[1] = gs * 8 + i1; rt.w[0] = ggate / sden; rt.w[1] = ggate * p1 / sden;
                rt.slot[0] = atomicAdd(&cnt[rt.e[0] * CNT_STRIDE], 1); rt.slot[1] = atomicAdd(&cnt[rt.e[1] * CNT_STRIDE], 1); rt.pad[0] = 0; rt.pad[1] = 0;
                list[rt.e[0] * RTOK + rt.slot[0]] = rowA; list[rt.e[1] * RTOK + rt.slot[1]] = rowA;
                route[rowA] = rt;
            }
        }
        __syncthreads();
        if (act) {
            const float* wn = p.nfw + (size_t)layer * D;
#pragma unroll 2
            for (int q = 0; q < 4; ++q) {
                const int rr = kq * 4 + q, tq = tl * 16 + rr, rq = (tq / LTOK) * PB + LEADP + (tq % LTOK);
                const float rsq = LG[16 * 48 + rr];
#pragma unroll
                for (int j = 0; j < 8; ++j) { const f32x4 u = *(const f32x4*)(h1 + (size_t)rq * D + 4 * lane + 256 * j) * rsq * *(const f32x4*)(wn + 4 * lane + 256 * j);
                    u32x2 o; o.x = cvt_pk_bf16(u.x, u.y); o.y = cvt_pk_bf16(u.z, u.w); *(u32x2*)(U + (size_t)rq * D + 4 * lane + 256 * j) = o; }
            }
        }
        __syncthreads();
    }
}

#ifndef MOE_LPT
#define MOE_LPT 0
#endif
__device__ __forceinline__ void moe_tables(const Params& p, int layer, LAS unsigned char* lds) {
    LAS int* tab = (LAS int*)(lds + LDS_TAB);
    if (opaque_tid() == 0) { const int* cnt = moe_cnt(p, layer); int acc = 0, ab = 0, as = 0;
        for (int e = 0; e < NE; ++e) { const int c = cnt[e * CNT_STRIDE]; tab[e] = c; tab[32 + e] = acc; acc += (c + MOE_TILE - 1) / MOE_TILE;
            const int rem = c % MOE_TILE, sm = (MOE_LPT && rem > 0 && rem <= MOE_TILE / 2) ? 1 : 0;
            tab[96 + e] = ab; tab[128 + e] = as; ab += (c + MOE_TILE - 1) / MOE_TILE - sm; as += sm; }
        tab[64] = acc; tab[65] = ab; }
    __syncthreads();
}
__device__ __forceinline__ int moe_find(LAS const int* tab, int ti) { int e = 0;
#pragma unroll 1
    for (int k = 1; k < NE; ++k) if (tab[32 + k] <= ti) e = k;
    return e; }
__device__ __forceinline__ void moe_unit(LAS const int* tab, int u, int& e, int& rt) {
    const int nb = tab[65]; const bool small = u >= nb; const int v = small ? u - nb : u, base = small ? 128 : 96;
    e = 0;
#pragma unroll 1
    for (int k = 1; k < NE; ++k) if (tab[base + k] <= v) e = k;
    rt = small ? tab[e] / MOE_TILE : v - tab[96 + e];
}
__device__ __forceinline__ int moe_half(int rows) { return (MOE_LPT && rows <= 64) ? 2 : (rows <= 128 ? 1 : 0); }

#ifndef MOE_XCD
#define MOE_XCD 1
#endif
#define MOE_VCU ((MOE_XCD && (gridDim.x % 8 == 0)) ? (int)((blockIdx.x % 8) * (gridDim.x / 8) + blockIdx.x / 8) : (int)blockIdx.x)
struct SchedMoe1 {
    static constexpr int ldb = DE * 2;
    LAS const int* tab; const int* list; const char* U; const char* W1; const char* W3; int G, c, force;
    __device__ bool next(int i, pg8::GU& u) const {
        const int Lx = i * G + c; if (Lx >= tab[64] * 4) return false;
        const int ct = Lx & 3; int e, rt; moe_unit(tab, Lx >> 2, e, rt); const int ti = tab[32 + e] + rt;
        u.a = U; const size_t wo = ((size_t)e * D * DE + ct * 128) * 2; u.b0 = W1 + wo; u.b1 = W3 + wo; u.r0 = ti * 256; u.c0 = ct * 128; u.ex = e | (rt << 8); u.half = force ? force : moe_half(tab[e] - rt * 256); return true; }
    __device__ int row(const pg8::GU& u, int r) const { const int e = u.ex & 255, rt = u.ex >> 8, c_ = tab[e]; int idx = rt * 256 + r; idx = idx < c_ ? idx : c_ - 1; return list[e * RTOK + idx]; }
};
struct EpiSwiglu {
    static constexpr bool PERM = false;
    bf16_t* H;
    __device__ __forceinline__ void operator()(const f32x4 (&acc)[2][2][4][2], const pg8::GU& u, int wr, int wc, int fr, int fq) const {
        const int row0 = u.r0 + wr * 64 + fr, col0 = u.c0 + wc * 32 + 4 * fq;
#pragma unroll
        for (int ai = 0; ai < 2; ++ai)
#pragma unroll
            for (int m = 0; m < 4; ++m) { bf16_t* rowp = H + (size_t)(row0 + ai * 128 + m * 16) * DE + col0;
#pragma unroll
                for (int n = 0; n < 2; ++n) { float h[4];
#pragma unroll
                    for (int k = 0; k < 4; ++k) h[k] = siluf_(acc[ai][0][m][n][k]) * acc[ai][1][m][n][k];
                    u32x2 o; o.x = cvt_pk_bf16(h[0], h[1]); o.y = cvt_pk_bf16(h[2], h[3]); NT_STORE(o, (u32x2*)(rowp + n * 16)); } }
    }
};
struct EpiBf16Store2 {
    static constexpr bool PERM = false;
    bf16_t* O; int ldc;
    __device__ __forceinline__ void operator()(const f32x4 (&acc)[2][2][4][2], const pg8::GU& u, int wr, int wc, int fr, int fq) const {
        const int row0 = u.r0 + wr * 64 + fr, col0 = u.c0 + wc * 32 + 4 * fq;
#pragma unroll
        for (int ai = 0; ai < 2; ++ai)
#pragma unroll
            for (int m = 0; m < 4; ++m) { bf16_t* rowp = O + (size_t)(row0 + ai * 128 + m * 16) * ldc + col0;
#pragma unroll
                for (int bj = 0; bj < 2; ++bj)
#pragma unroll
                    for (int n = 0; n < 2; ++n) { const f32x4 v = acc[ai][bj][m][n]; u32x2 o; o.x = cvt_pk_bf16(v[0], v[1]); o.y = cvt_pk_bf16(v[2], v[3]); NT_STORE(o, (u32x2*)(rowp + bj * 128 + n * 16)); } }
    }
};
__device__ __forceinline__ void phase_e1(const Params& p, int layer, LAS unsigned char* lds, int force = 0) {
    moe_tables(p, layer, lds);
    SchedMoe1 S; S.tab = (LAS const int*)(lds + LDS_TAB); S.list = (const int*)(p.ws + WS_LIST); S.U = (const char*)(p.ws + WS_U);
    S.W1 = (const char*)(p.ws + WS_W1T) + (size_t)layer * NE * DE * D * 2; S.W3 = (const char*)(p.ws + WS_W3T) + (size_t)layer * NE * DE * D * 2; S.G = gridDim.x; S.c = MOE_VCU; S.force = force;
    EpiSwiglu E{(bf16_t*)(p.ws + WS_HB)};
    pg8::gemm_phase<EpiSwiglu, SchedMoe1, true, 1>(lds, D, S, E);
}
struct SchedMoe2 {
    static constexpr int ldb = D * 2;
    LAS const int* tab; const char* H; const char* W2; int G, c;
    __device__ bool next(int i, pg8::GU& u) const {
        const int Lx = i * G + c; if (Lx >= tab[64] * 8) return false;
        const int ct = Lx & 7; int e, rt; moe_unit(tab, Lx >> 3, e, rt); const int ti = tab[32 + e] + rt;
        u.a = H + (size_t)ti * 256 * DE * 2; u.b0 = W2 + ((size_t)e * DE * D + ct * 256) * 2; u.b1 = u.b0 + 256; u.r0 = ti * 256; u.c0 = ct * 256; u.ex = e; u.half = moe_half(tab[e] - rt * 256); return true; }
    __device__ int row(const pg8::GU&, int) const { return 0; }
};
__device__ __forceinline__ void phase_e2(const Params& p, int layer, LAS unsigned char* lds) {
    moe_tables(p, layer, lds);
    SchedMoe2 S; S.tab = (LAS const int*)(lds + LDS_TAB); S.H = (const char*)(p.ws + WS_HB); S.W2 = (const char*)(p.ws + WS_W2T) + (size_t)layer * NE * D * DE * 2; S.G = gridDim.x; S.c = MOE_VCU;
    EpiBf16Store2 E{(bf16_t*)(p.ws + WS_YB), D};
    pg8::gemm_phase<EpiBf16Store2, SchedMoe2, false, 1>(lds, DE, S, E);
}

__device__ __forceinline__ int combine_excl(const Params& p, int layer, int lane) {
    const int* cnt = moe_cnt(p, layer);
    int nt = 0; if (lane < NE) nt = (cnt[lane * CNT_STRIDE] + MOE_TILE - 1) / MOE_TILE;
    int incl = nt;
#pragma unroll
    for (int o = 1; o < 32; o <<= 1) { const int t = __shfl_up(incl, o); if (lane >= o) incl += t; }
    return incl - nt;
}
__device__ __forceinline__ void load_combined(const Params& p, int excl, int r, int lane, f32x4 (&v)[8]) {
    const Route q = ((const Route*)(p.ws + WS_ROUTE))[r];
    const size_t r0 = (size_t)(__shfl(excl, q.e[0]) * MOE_TILE + q.slot[0]) * D, r1 = (size_t)(__shfl(excl, q.e[1]) * MOE_TILE + q.slot[1]) * D;
    const float* h1 = (const float*)(p.ws + WS_H1) + (size_t)r * D; const bf16_t* Y = (const bf16_t*)(p.ws + WS_YB);
#pragma unroll
    for (int j = 0; j < 8; ++j) {
        const f32x4 h = N1_LD((const f32x4*)(h1 + 4 * lane + 256 * j));
        const u32x2 a = N1_LD((const u32x2*)(Y + r0 + 4 * lane + 256 * j)), bq = N1_LD((const u32x2*)(Y + r1 + 4 * lane + 256 * j));
        v[j].x = h.x + q.w[0] * bflo(a.x) + q.w[1] * bflo(bq.x); v[j].y = h.y + q.w[0] * bfhi(a.x) + q.w[1] * bfhi(bq.x);
        v[j].z = h.z + q.w[0] * bflo(a.y) + q.w[1] * bflo(bq.y); v[j].w = h.w + q.w[0] * bfhi(a.y) + q.w[1] * bfhi(bq.y);
    }
}
template <>
__device__ __forceinline__ void n1_load_row<2>(const Params& p, const N1Src& sr, int excl, int r, int lane, f32x4 (&v)[8]) {
    const int pp = r % PB;
    if (pp < LEADP) {
#pragma unroll
        for (int j = 0; j < 8; ++j) v[j] = (f32x4){0.f, 0.f, 0.f, 0.f};
    } else { (void)sr; load_combined(p, excl, r, lane, v); }
}
__device__ __forceinline__ void phase_fn(const Params& p) {
    const int tid = opaque_tid(), lane = tid & 63, wave = __builtin_amdgcn_readfirstlane(tid >> 6);
    const int gw = blockIdx.x * NWAVES + wave, NGW = gridDim.x * NWAVES;
    f32x4 wv[8];
#pragma unroll
    for (int j = 0; j < 8; ++j) wv[j] = *(const f32x4*)(p.fnw + 4 * lane + 256 * j);
    const int excl = combine_excl(p, DEPTH - 1, lane);
    for (int task = gw; task < NB * SEQ; task += NGW) {
        const int b = task / SEQ, s = task % SEQ, r = b * PB + 64 + s;
        f32x4 v[8]; load_combined(p, excl, r, lane, v);
        float ss = 0.f;
#pragma unroll
        for (int j = 0; j < 8; ++j) ss += (v[j].x * v[j].x + v[j].y * v[j].y) + (v[j].z * v[j].z + v[j].w * v[j].w);
        const float rs = rsqrtf(wave_sum(ss) * (1.f / D) + EPS);
#pragma unroll
        for (int j = 0; j < 8; ++j) { const f32x4 o_ = v[j] * rs * wv[j]; __builtin_nontemporal_store(o_, (f32x4*)(p.out + (size_t)task * D + 4 * lane + 256 * j)); }
    }
}
constexpr int CW_QHEAD = 8192;
constexpr int QPER = NE * D * DE / 4096;
constexpr int QITEMS = 3 * QPER;
static_assert(WS_W3T - WS_W1T == WS_W2T - WS_W3T, "the three bf16 expert-weight copies are equally spaced");
__device__ __forceinline__ void convert_items(LAS unsigned char* lds, int layer, int first, int n) {
    const int tid = opaque_tid();
    unsigned char* ws = (unsigned char*)lds_ptr(lds, 26);
    for (int it = first; it < first + n; ++it) {
#ifndef CONV_REV
#define CONV_REV 0
#endif
#ifndef CONV_NT
#define CONV_NT 1
#endif
        const int w = CONV_REV ? 2 - it / QPER : it / QPER, off = it % QPER;
        const size_t e0 = (((size_t)layer * QPER + off) * 512 + tid) * 8;
        const float* src = (const float*)lds_ptr(lds, 21 + w) + e0;
        bf16_t* dst = (bf16_t*)(ws + WS_W1T + (size_t)w * (WS_W3T - WS_W1T)) + e0;
        const f32x4 a = __builtin_nontemporal_load((const f32x4*)src), b = __builtin_nontemporal_load((const f32x4*)(src + 4));
        u32x4 o; o.x = cvt_pk_bf16(a.x, a.y); o.y = cvt_pk_bf16(a.z, a.w); o.z = cvt_pk_bf16(b.x, b.y); o.w = cvt_pk_bf16(b.z, b.w);
        if (CONV_NT) __builtin_nontemporal_store(o, (u32x4*)dst); else *(u32x4*)dst = o;
    }
}
constexpr int CW_DONE = 8192 + 256;
__device__ __forceinline__ void convert_until(const Params& p, LAS unsigned char* lds, int lfirst, int llast, int phase_id, int my_units, int total_units) {
    LAS int* slot = (LAS int*)(lds + LDS_QSLOT);
    unsigned* donew = (unsigned*)(p.ws + WS_CTL) + CW_DONE + 64 * phase_id;
    if (threadIdx.x == 0 && my_units > 0) (void)__hip_atomic_fetch_add(donew, (unsigned)my_units, __ATOMIC_RELAXED, __HIP_MEMORY_SCOPE_AGENT);
    int layer = lfirst;
    for (int it = 0; it < 8192; ++it) {
        if (layer > llast || layer >= DEPTH) break;
        if (threadIdx.x == 0) {
            const unsigned dn = __hip_atomic_load(donew, __ATOMIC_RELAXED, __HIP_MEMORY_SCOPE_AGENT);
            int v = -1;
            if (dn < (unsigned)total_units) v = (int)__hip_atomic_fetch_add((unsigned*)(p.ws + WS_CTL) + CW_QHEAD + 64 * layer, 2u, __ATOMIC_RELAXED, __HIP_MEMORY_SCOPE_AGENT);
            *slot = v; }
        __syncthreads();
        const int base = __builtin_amdgcn_readfirstlane(*slot);
        __syncthreads();
        if (base < 0) break;
        if (base >= QITEMS) { ++layer; continue; }
        convert_items(lds, layer, base, 2 < QITEMS - base ? 2 : QITEMS - base);
    }
}
__device__ __forceinline__ void convert_bg(const Params& p, LAS unsigned char* lds, int lfirst, int llast, int budget) {
    LAS int* slot = (LAS int*)(lds + LDS_QSLOT);
    for (int layer = lfirst; layer <= llast && layer < DEPTH; ++layer) {
        unsigned* qh = (unsigned*)(p.ws + WS_CTL) + CW_QHEAD + 64 * layer;
        while (budget > 0) {
            const int n = budget < 8 ? budget : 8;
            if (threadIdx.x == 0) *slot = (int)__hip_atomic_fetch_add(qh, (unsigned)n, __ATOMIC_RELAXED, __HIP_MEMORY_SCOPE_AGENT);
            __syncthreads();
            const int base = __builtin_amdgcn_readfirstlane(*slot);
            __syncthreads();
            if (base >= QITEMS) break;
            convert_items(lds, layer, base, n < QITEMS - base ? n : QITEMS - base);
            budget -= n;
        }
    }
}
#ifndef RPT_P0
#define RPT_P0 1
#endif
#ifndef RPT_N1
#define RPT_N1 1
#endif
#ifndef RPT_G1
#define RPT_G1 1
#endif
#ifndef RPT_MA
#define RPT_MA 1
#endif
#ifndef RPT_MC
#define RPT_MC 1
#endif
#ifndef RPT_G2
#define RPT_G2 1
#endif
#ifndef RPT_E1
#define RPT_E1 1
#endif
#ifndef RPT_E2
#define RPT_E2 1
#endif
#ifndef RPT_FN
#define RPT_FN 1
#endif
#ifndef RPT_N2
#define RPT_N2 1
#endif
#ifndef RPT_MAB
#define RPT_MAB 1
#endif
#ifndef RPT_E1B
#define RPT_E1B 1
#endif
#ifndef RPT_E2B
#define RPT_E2B 1
#endif
#ifndef RPT_E1F
#define RPT_E1F 1
#endif
#ifndef E1FORCE
#define E1FORCE 2
#endif
#ifndef RPT_BAR
#define RPT_BAR 1
#endif

__device__ __forceinline__ Params load_params(LAS unsigned char* lds) {
    asm volatile("" ::: "memory");
    Params p;
    p.x = (const float*)lds_ptr(lds, 0); p.meta = (const float*)lds_ptr(lds, 1); p.lbl = (const float*)lds_ptr(lds, 2); p.nmw = (const float*)lds_ptr(lds, 3); p.w_in = (const float*)lds_ptr(lds, 4);
    p.hgnw = (const float*)lds_ptr(lds, 5); p.mbi = (const float*)lds_ptr(lds, 6); p.mbf = (const float*)lds_ptr(lds, 7); p.mlnw = (const float*)lds_ptr(lds, 8); p.cw = (const float*)lds_ptr(lds, 9);
    p.cb = (const float*)lds_ptr(lds, 10); p.dtb = (const float*)lds_ptr(lds, 11); p.alog = (const float*)lds_ptr(lds, 12); p.dsk = (const float*)lds_ptr(lds, 13); p.ssnw = (const float*)lds_ptr(lds, 14);
    p.w_out = (const float*)lds_ptr(lds, 15); p.nfw = (const float*)lds_ptr(lds, 16); p.wg = (const float*)lds_ptr(lds, 17); p.bg = (const float*)lds_ptr(lds, 18); p.wr = (const float*)lds_ptr(lds, 19);
    p.br = (const float*)lds_ptr(lds, 20); p.w1 = (const float*)lds_ptr(lds, 21); p.w3 = (const float*)lds_ptr(lds, 22); p.w2 = (const float*)lds_ptr(lds, 23); p.fnw = (const float*)lds_ptr(lds, 24);
    p.out = (float*)lds_ptr(lds, 25); p.ws = (unsigned char*)lds_ptr(lds, 26);
    return p;
}
__device__ __forceinline__ void grid_bar(LAS unsigned char* lds) {
    asm volatile("" ::: "memory");
    XcdBarrier b; b.bar = (unsigned*)((unsigned char*)lds_ptr(lds, 26) + WS_CTL) + CW_BAR;
    b.x = (unsigned)__builtin_amdgcn_readfirstlane((int)*(const LAS unsigned*)(lds + LDS_PARAMS + 8 * 27)); b.st = (volatile LAS unsigned*)(lds + LDS_BARW);
    xcd_barrier(b);
}
#if MOE_FP32
#define convert_bg(...) ((void)0)
#define MOE_E1 phase_e1x
#define MOE_E2 phase_e2x
#else
#define MOE_E1 phase_e1
#define MOE_E2 phase_e2
#endif
__global__ void __launch_bounds__(NTHREADS, 2) k_mega(Params pk) {
    extern __shared__ __attribute__((aligned(16))) unsigned char lds_raw[];
    LAS unsigned char* lds = (LAS unsigned char*)lds_raw;
    if (threadIdx.x == 0) {
        *(LAS u32x4*)(lds + LDS_BARW) = (u32x4){0u, 0u, 0u, 0u};
        LAS unsigned long long* q = (LAS unsigned long long*)(lds + LDS_PARAMS);
        q[0] = (unsigned long long)pk.x; q[1] = (unsigned long long)pk.meta; q[2] = (unsigned long long)pk.lbl; q[3] = (unsigned long long)pk.nmw; q[4] = (unsigned long long)pk.w_in;
        q[5] = (unsigned long long)pk.hgnw; q[6] = (unsigned long long)pk.mbi; q[7] = (unsigned long long)pk.mbf; q[8] = (unsigned long long)pk.mlnw; q[9] = (unsigned long long)pk.cw;
        q[10] = (unsigned long long)pk.cb; q[11] = (unsigned long long)pk.dtb; q[12] = (unsigned long long)pk.alog; q[13] = (unsigned long long)pk.dsk; q[14] = (unsigned long long)pk.ssnw;
        q[15] = (unsigned long long)pk.w_out; q[16] = (unsigned long long)pk.nfw; q[17] = (unsigned long long)pk.wg; q[18] = (unsigned long long)pk.bg; q[19] = (unsigned long long)pk.wr;
        q[20] = (unsigned long long)pk.br; q[21] = (unsigned long long)pk.w1; q[22] = (unsigned long long)pk.w3; q[23] = (unsigned long long)pk.w2; q[24] = (unsigned long long)pk.fnw;
        q[25] = (unsigned long long)pk.out; q[26] = (unsigned long long)pk.ws;
    }
    __syncthreads();
    { const XcdBarrier b0 = xcd_barrier_post((unsigned*)(pk.ws + WS_CTL) + CW_BAR, (volatile LAS unsigned*)(lds + LDS_BARW));
      if (threadIdx.x == 0) *(LAS unsigned*)(lds + LDS_PARAMS + 8 * 27) = b0.x; }
    __syncthreads();
#define PH(stmt) do { { const Params p = load_params(lds); stmt; } for (int _b = 0; _b < RPT_BAR; ++_b) grid_bar(lds); } while (0)
#define PHR(n, stmt) do { for (int _r = 0; _r < (n); ++_r) PH(stmt); } while (0)
    for (int _r = 0; _r < RPT_P0; ++_r) { const Params p = load_params(lds); phase_p0(p, lds); }
#ifndef BG_G1
#define BG_G1 40
#endif
#ifndef BG_MA
#define BG_MA 8
#endif
#ifndef BG_MC
#define BG_MC 15
#endif
#ifndef BG_G2
#define BG_G2 45
#endif
#ifndef BG_E1
#define BG_E1 45
#endif
#ifndef BG_E2
#define BG_E2 14
#endif
    const int bx = blockIdx.x, G_ = gridDim.x;
#define MY_UNITS(total) ((bx < (total)) ? (((total) - bx + G_ - 1) / G_) : 0)
#define IDLE_UNITS(total) ((((total) + G_ - 1) / G_) - ((bx < (total)) ? (((total) - bx + G_ - 1) / G_) : 0))
#define IDLE_UNITS_C(total, cc) ((((total) + G_ - 1) / G_) - (((cc) < (total)) ? (((total) - (cc) + G_ - 1) / G_) : 0))
#ifndef DYN_FILL
#define DYN_FILL 0
#endif
#define MY_UNITS_C(total, cc) (((cc) < (total)) ? (((total) - (cc) + G_ - 1) / G_) : 0)
#define LAYER(layer) do { N1Src src{}; src.layer_prev = (layer) - 1; \
        PHR(RPT_N1, if ((layer) == 0) phase_n1<0>(p, (layer), src); else phase_n1<2>(p, (layer), src)); \
        PHR(RPT_G1, phase_g1(p, (layer), lds); if (DYN_FILL) convert_until(p, lds, (layer), DEPTH - 1, (layer) * 8 + 0, MY_UNITS_C((R / 256) * (NPROJX / 256), bx), (R / 256) * (NPROJX / 256)); else convert_bg(p, lds, (layer), DEPTH - 1, BG_G1 * IDLE_UNITS((R / 256) * (NPROJX / 256)))); \
        PHR(RPT_MA, phase_mix<false>(p, (layer), lds); convert_bg(p, lds, (layer), DEPTH - 1, BG_MA * IDLE_UNITS(3 * NCH * 4))); \
        PH(phase_scan(p)); \
        for (int _n = 1; _n < RPT_MAB; ++_n) { PH(phase_mix<false>(p, (layer), lds)); PH(phase_scan(p)); } \
        PHR(RPT_MC, phase_mix<true>(p, (layer), lds); convert_bg(p, lds, (layer), DEPTH - 1, BG_MC * IDLE_UNITS(3 * NCH * 4))); \
        PHR(RPT_G2, phase_g2(p, (layer), lds); if (DYN_FILL) convert_until(p, lds, (layer), DEPTH - 1, (layer) * 8 + 3, MY_UNITS_C((R / 256) * (D / 256), bx), (R / 256) * (D / 256)); else convert_bg(p, lds, (layer), DEPTH - 1, BG_G2 * IDLE_UNITS((R / 256) * (D / 256)))); \
        for (int _n = 1; _n < RPT_N2; ++_n) { PH(phase_n2(p, (layer), lds)); PH(if (blockIdx.x == 0 && threadIdx.x < 32) moe_cnt(p, (layer))[threadIdx.x * CNT_STRIDE] = 0); } \
        PH(phase_n2(p, (layer), lds); convert_bg(p, lds, (layer), (layer), QITEMS)); \
        for (int _n = 1; _n < ((layer) == 1 ? RPT_E1F : 1); ++_n) PH(phase_e1(p, (layer), lds, E1FORCE)); \
        PHR(((layer) == 1 ? RPT_E1B : 1) * RPT_E1, MOE_E1(p, (layer), lds); { const int T_ = 4 * *(const LAS int*)(lds + LDS_TAB + 256); if (DYN_FILL) convert_until(p, lds, (layer) + 1, DEPTH - 1, (layer) * 8 + 4, MY_UNITS_C(T_, MOE_VCU), T_); else convert_bg(p, lds, (layer) + 1, DEPTH - 1, BG_E1 * IDLE_UNITS_C(T_, MOE_VCU)); }); \
        PHR(((layer) == 1 ? RPT_E2B : 1) * RPT_E2, MOE_E2(p, (layer), lds); { const int T_ = 8 * *(const LAS int*)(lds + LDS_TAB + 256); if (DYN_FILL) convert_until(p, lds, (layer) + 1, DEPTH - 1, (layer) * 8 + 5, MY_UNITS_C(T_, MOE_VCU), T_); else convert_bg(p, lds, (layer) + 1, DEPTH - 1, BG_E2 * IDLE_UNITS_C(T_, MOE_VCU)); }); } while (0)
    static_assert(DEPTH == 2, "two layers written out");
    LAYER(0);
    LAYER(1);
#undef LAYER
    for (int _r = 0; _r < RPT_FN; ++_r) { const Params p = load_params(lds); phase_fn(p); }
#undef PH
}

extern "C" void kernel_launch(void* const* d_in, const int* in_sizes, int n_in, void* d_out, int out_size, void* d_ws, size_t ws_size, hipStream_t stream) {
    Params p{};
    p.x = (const float*)d_in[0]; p.meta = (const float*)d_in[1]; p.lbl = (const float*)d_in[2]; p.nmw = (const float*)d_in[3]; p.w_in = (const float*)d_in[4];
    p.hgnw = (const float*)d_in[5]; p.mbi = (const float*)d_in[6]; p.mbf = (const float*)d_in[7]; p.mlnw = (const float*)d_in[8]; p.cw = (const float*)d_in[9];
    p.cb = (const float*)d_in[10]; p.dtb = (const float*)d_in[11]; p.alog = (const float*)d_in[12]; p.dsk = (const float*)d_in[13]; p.ssnw = (const float*)d_in[14];
    p.w_out = (const float*)d_in[15]; p.nfw = (const float*)d_in[16]; p.wg = (const float*)d_in[17]; p.bg = (const float*)d_in[18]; p.wr = (const float*)d_in[19];
    p.br = (const float*)d_in[20]; p.w1 = (const float*)d_in[21]; p.w3 = (const float*)d_in[22]; p.w2 = (const float*)d_in[23]; p.fnw = (const float*)d_in[24];
    p.out = (float*)d_out; p.ws = (unsigned char*)d_ws;
    static int grid = 0;
    if (grid == 0) {
        int dev = 0, cus = 0, per_cu = 0;
        (void)hipGetDevice(&dev); (void)hipDeviceGetAttribute(&cus, hipDeviceAttributeMultiprocessorCount, dev);
        (void)hipFuncSetAttribute((const void*)k_mega, hipFuncAttributeMaxDynamicSharedMemorySize, LDS_BYTES);
        (void)hipOccupancyMaxActiveBlocksPerMultiprocessor(&per_cu, (const void*)k_mega, NTHREADS, LDS_BYTES);
        (void)hipGetLastError();
        grid = (per_cu >= 1 && cus > 0) ? cus : -1;
        if (WS_END > ws_size) { fprintf(stderr, "workspace too small: need %zu have %zu\n", (size_t)WS_END, ws_size); grid = -1; }
    }
    (void)n_in; (void)in_sizes; (void)out_size;
    if (grid < 0) return;
    (void)hipMemsetAsync((char*)d_ws + WS_CTL, 0, CTL_BYTES, stream);
    hipLaunchKernelGGL(k_mega, dim3(grid), dim3(NTHREADS), LDS_BYTES, stream, p);
}
```

```cpp
#include <hip/hip_runtime.h>
#include <stdint.h>
#include <cstdio>

#define LAS __attribute__((address_space(3)))
#define GAS __attribute__((address_space(1)))
typedef unsigned short bf16_t;
typedef short bf16x8 __attribute__((ext_vector_type(8)));
typedef short bf16x4 __attribute__((ext_vector_type(4)));
typedef float f32x4 __attribute__((ext_vector_type(4)));
typedef float f32x2 __attribute__((ext_vector_type(2)));
typedef unsigned u32x4 __attribute__((ext_vector_type(4)));
typedef unsigned u32x2 __attribute__((ext_vector_type(2)));

constexpr int D = 2048, NB = 4, SEQ = 2048, NMETA = 16, LTOK = SEQ + NMETA, DEPTH = 2;
constexpr int PB = 2112;
constexpr int LEADP = 48;
constexpr int R = NB * PB;
constexpr int NCH = R / 64;
constexpr int CPB = 33;
constexpr int D_IN = 6680, NPROJ = 6656, NGATE = 24;
constexpr int P_HQ = 0, P_HF = 512, P_HI = 1024, P_HG = 1536, P_MQ = 2048, P_MK = 2304, P_MV = 2560, P_MO = 3072, P_SZ = 3584, P_SX = 4608, P_SB = 5632, P_SC = 6144;
constexpr int NE = 32, DE = 512;
constexpr float EPS = 1e-6f;
constexpr int NTHREADS = 512, NWAVES = 8;

typedef __bf16 bf16n2 __attribute__((ext_vector_type(2)));
__device__ __forceinline__ unsigned cvt_pk_bf16(float lo, float hi) { bf16n2 v; v[0] = (__bf16)lo; v[1] = (__bf16)hi; return __builtin_bit_cast(unsigned, v); }
__device__ __forceinline__ bf16_t f2bf(float f) { return (bf16_t)(cvt_pk_bf16(f, 0.f) & 0xffffu); }
__device__ __forceinline__ float bf2f(bf16_t b) { return __uint_as_float(((unsigned)b) << 16); }
__device__ __forceinline__ float bflo(unsigned w) { return __uint_as_float(w << 16); }
__device__ __forceinline__ float bfhi(unsigned w) { return __uint_as_float(w & 0xffff0000u); }
__device__ __forceinline__ void unpack8(const u32x4 w, float (&f)[8]) { f[0] = bflo(w.x); f[1] = bfhi(w.x); f[2] = bflo(w.y); f[3] = bfhi(w.y); f[4] = bflo(w.z); f[5] = bfhi(w.z); f[6] = bflo(w.w); f[7] = bfhi(w.w); }
__device__ __forceinline__ u32x4 pack8(const float (&f)[8]) { u32x4 w; w.x = cvt_pk_bf16(f[0], f[1]); w.y = cvt_pk_bf16(f[2], f[3]); w.z = cvt_pk_bf16(f[4], f[5]); w.w = cvt_pk_bf16(f[6], f[7]); return w; }
__device__ __forceinline__ int opaque_tid() { int t = threadIdx.x; asm volatile("" : "+v"(t)); return t; }
template <int CTRL, int ROWMASK> __device__ __forceinline__ float dpp_add_step(float v) {
    const int t = __builtin_amdgcn_update_dpp(0, __builtin_bit_cast(int, v), CTRL, ROWMASK, 0xF, false);
    return v + __builtin_bit_cast(float, t);
}
__device__ __forceinline__ float sum16_dpp(float v) {
    v = dpp_add_step<0xB1, 0xF>(v); v = dpp_add_step<0x4E, 0xF>(v); v = dpp_add_step<0x141, 0xF>(v); v = dpp_add_step<0x140, 0xF>(v);
    return v;
}
__device__ __forceinline__ float sum32_dpp(float v, int lane) {
    v = sum16_dpp(v);
    v = dpp_add_step<0x142, 0xA>(v);
    const float lo = __builtin_bit_cast(float, __builtin_amdgcn_readlane(__builtin_bit_cast(int, v), 31)), hi = __builtin_bit_cast(float, __builtin_amdgcn_readlane(__builtin_bit_cast(int, v), 63));
    return lane < 32 ? lo : hi;
}
__device__ __forceinline__ float wave_sum(float v) {
    v = dpp_add_step<0xB1, 0xF>(v);
    v = dpp_add_step<0x4E, 0xF>(v);
    v = dpp_add_step<0x141, 0xF>(v);
    v = dpp_add_step<0x140, 0xF>(v);
    v = dpp_add_step<0x142, 0xA>(v);
    v = dpp_add_step<0x143, 0xC>(v);
    return __builtin_bit_cast(float, __builtin_amdgcn_readlane(__builtin_bit_cast(int, v), 63));
}
__device__ __forceinline__ float sigmoidf_(float x) { return __builtin_amdgcn_rcpf(1.f + __expf(-x)); }
__device__ __forceinline__ float siluf_(float x) { return x * __builtin_amdgcn_rcpf(1.f + __expf(-x)); }
__device__ __forceinline__ float softplusf_(float x) { return x > 20.f ? x : log1pf(__expf(x)); }
__device__ __forceinline__ float logsigmoidf_(float x) { return fminf(x, 0.f) - log1pf(__expf(-fabsf(x))); }
#define LDS_WAIT() asm volatile("s_waitcnt lgkmcnt(0)" ::: "memory")
#define VM_WAIT() asm volatile("s_waitcnt vmcnt(0)" ::: "memory")

#define XB_TMO      128
#define XB_XCNT(j)  (256  + 64 * (j))
#define XB_XSUB(j)  (1280 + 64 * (j))
#define XB_XGEN(j)  (2304 + 64 * (j))
#define XB_TOP      3328
#define XB_TOPGEN   3392
#define XCD_BAR_WORDS 3456
#define XB_SPIN_CAP (1u << 18)
__device__ __forceinline__ unsigned xb_ld(unsigned* p)              { return __hip_atomic_load(p, __ATOMIC_RELAXED, __HIP_MEMORY_SCOPE_AGENT); }
__device__ __forceinline__ unsigned xb_add(unsigned* p, unsigned v) { return __hip_atomic_fetch_add(p, v, __ATOMIC_RELAXED, __HIP_MEMORY_SCOPE_AGENT); }
__device__ __forceinline__ unsigned xb_xcc_id() { return (unsigned)__builtin_amdgcn_s_getreg((3 << 11) | 20) & 0xFu; }
#define XB_SPIN(cond, bar) do { unsigned _sp = 0; while (cond) { __builtin_amdgcn_s_sleep(1); \
    if ((++_sp & 255u) == 0u) { if (xb_ld(&(bar)[XB_TMO])) break; if (_sp > XB_SPIN_CAP) { atomicAdd(&(bar)[XB_TMO], 1u); break; } } } } while (0)
struct XcdBarrier { unsigned* bar; unsigned x; volatile LAS unsigned* st; };
__device__ __forceinline__ XcdBarrier xcd_barrier_post(unsigned* bar, volatile LAS unsigned* st) {
    XcdBarrier b; b.bar = bar; b.x = xb_xcc_id(); b.st = st;
    if (threadIdx.x == 0) (void)xb_add(&bar[XB_XCNT(b.x)], 1u);
    return b;
}
__device__ __forceinline__ void xcd_barrier_complete(unsigned* bar, unsigned x, unsigned& nloc, unsigned& nx) {
    const unsigned G = gridDim.x * gridDim.y * gridDim.z;
    unsigned sum, cnt, mine, sp = 0u;
    for (;;) {
        sum = 0u; cnt = 0u; mine = 0u;
#pragma unroll
        for (unsigned j = 0; j < 16; ++j) { const unsigned c = xb_ld(&bar[XB_XCNT(j)]); sum += c; cnt += (c > 0u) ? 1u : 0u; mine = (j == x) ? c : mine; }
        if (sum == G) break;
        __builtin_amdgcn_s_sleep(1);
        if ((++sp & 255u) == 0u) { if (xb_ld(&bar[XB_TMO])) break; if (sp > XB_SPIN_CAP) { atomicAdd(&bar[XB_TMO], 1u); break; } }
    }
    nloc = mine > 0u ? mine : 1u; nx = cnt > 0u ? cnt : 1u;
}
__device__ __forceinline__ void xcd_barrier(const XcdBarrier& b) {
    asm volatile("s_waitcnt vmcnt(0)" ::: "memory");
    __syncthreads();
    if (threadIdx.x == 0) {
        unsigned* bar = b.bar;
        __builtin_amdgcn_s_waitcnt(0);
        unsigned nloc = b.st[0], nx = b.st[1];
        if (nloc == 0u) { xcd_barrier_complete(bar, b.x, nloc, nx); b.st[0] = nloc; b.st[1] = nx; }
        const unsigned old = xb_add(&bar[XB_XSUB(b.x)], 1u);
        const unsigned gen = old / nloc;
        if (old + 1u == (gen + 1u) * nloc) {
            __builtin_amdgcn_fence(__ATOMIC_RELEASE, "agent");
            asm volatile("s_waitcnt vmcnt(0)" ::: "memory");
            const unsigned og = xb_add(&bar[XB_TOP], 1u);
            const unsigned tg = og / nx;
            if (og + 1u == (tg + 1u) * nx) xb_add(&bar[XB_TOPGEN], 1u);
            else XB_SPIN(xb_ld(&bar[XB_TOPGEN]) == tg, bar);
            __builtin_amdgcn_fence(__ATOMIC_ACQUIRE, "agent");
            xb_add(&bar[XB_XGEN(b.x)], 1u);
            asm volatile("s_waitcnt vmcnt(0)" ::: "memory");
        } else {
            XB_SPIN(xb_ld(&bar[XB_XGEN(b.x)]) == gen, bar);
            __builtin_amdgcn_fence(__ATOMIC_ACQUIRE, "agent");
            asm volatile("s_waitcnt vmcnt(0)" ::: "memory");
        }
    }
    __syncthreads();
}
namespace pg8 {
#ifndef PG8_WGM
#define PG8_WGM 8
#endif
constexpr int BM = 256, BK = 64, HALF = 128, HTB = HALF * BK * 2, STAGE_BYTES = 8 * HTB, NXCD = 8, WGM = PG8_WGM;
__host__ __device__ __forceinline__ int lds_byte(int r, int c) { const int st = (r >> 4) * 2 + (c >> 5), rr = r & 15, cc = c & 31, ob = rr * 64 + cc * 2; return st * 1024 + (ob ^ (((ob >> 9) & 1) << 5)); }
__host__ __device__ __forceinline__ void stage_rc(int b, int& Rr, int& C) { const int st = b / 1024, sb = b % 1024, swz = sb ^ (((sb >> 9) & 1) << 5); Rr = (st >> 1) * 16 + swz / 64; C = (st & 1) * 32 + (swz % 64) / 2; }
__host__ __device__ __forceinline__ int perm32(int rho) { const int n = rho >> 4, i = rho & 15; return 8 * (i >> 2) + 4 * n + (i & 3); }

struct GU { const char* a; const char* b0; const char* b1; int r0; int c0; int ex; int half; };

struct TileOrder {
    int nM, nN, nwg, G, c;
    __device__ void init(int nM_, int nN_, int G_, int c_) { nM = nM_; nN = nN_; nwg = nM * nN; G = G_; c = c_; }
    __device__ bool tile(int i, int& pm, int& pn) const {
        const long Lx = (long)i * G + c; if (Lx >= nwg) return false;
        int wgid = (int)Lx; { const int q = nwg / NXCD, r = nwg % NXCD, xcd = wgid % NXCD, off = wgid / NXCD; wgid = (xcd < r ? xcd * (q + 1) : r * (q + 1) + (xcd - r) * q) + off; }
        const int nig = WGM * nN, gid = wgid / nig, fm = gid * WGM, gsz = (nM - fm) < WGM ? (nM - fm) : WGM;
        pm = fm + ((wgid % nig) % gsz); pn = (wgid % nig) / gsz; return true;
    }
};

template <class Epi, class Sched, bool GATHER, int BMODE = 0>
__device__ __forceinline__ void gemm_phase(LAS unsigned char* lds, const int K, const Sched& S, const Epi& E) {
    const int tid = opaque_tid(), wid = __builtin_amdgcn_readfirstlane(tid >> 6), lane = tid & 63, wr = wid >> 2, wc = wid & 3, fr = lane & 15, fq = lane >> 4;
    const int nt = K / BK;
    unsigned voffB[2], vAc[2][2], vAn[2][2];
#pragma unroll
    for (int i = 0; i < 2; ++i) { int Rr_, Cc_; stage_rc(tid * 16 + i * 8192, Rr_, Cc_); const int Rb = Epi::PERM ? ((Rr_ & ~31) + perm32(Rr_ & 31)) : Rr_;
        if constexpr (BMODE == 0) voffB[i] = (unsigned)(Rb * K + Cc_) * 2u;
        else { static_assert(BMODE == 0 || !Epi::PERM, "BMODE 1 needs PERM == false"); const int c = wid * 64 + i * 512 + lane, k = c >> 4, slot = c & 15, ch = slot ^ (((k & 3) << 2) | ((k >> 2) & 3));
            voffB[i] = (unsigned)k * (unsigned)S.ldb + (unsigned)ch * 16u; } }
    const size_t kstep = (size_t)(BK * 2);
    size_t kstepB = kstep; if constexpr (BMODE == 1) kstepB = (size_t)BK * (size_t)S.ldb;
    unsigned tb[2][2];
    if constexpr (BMODE == 1) { const int q = fr >> 2, pq = fr & 3;
#pragma unroll
        for (int n = 0; n < 2; ++n)
#pragma unroll
            for (int t = 0; t < 2; ++t) { const int row = 8 * fq + 4 * t + q, chunk = wc * 4 + 2 * n + (pq >> 1), swz = (q << 2) | ((2 * fq + t) & 3);
                tb[n][t] = (unsigned)(size_t)lds + (unsigned)(4 * HTB + 256 * row + 16 * (chunk ^ swz) + 8 * (pq & 1)); } }
    const unsigned ldsw = (unsigned)wid * 1024u;
    const int aoff = lds_byte(wr * 64 + fr, fq * 8), boff = lds_byte(wc * 32 + fr, fq * 8);
#define PG8_SA(b, h) (((b) * 2 + (h)) * HTB)
#define PG8_SB(b, h) ((4 + (b) * 2 + (h)) * HTB)
#define PG8_STAGE(bufoff, gbase, voff) do { _Pragma("unroll") for (int _i = 0; _i < 2; ++_i) \
        __builtin_amdgcn_global_load_lds((const unsigned*)((const char*)(gbase) + (voff)[_i]), (LAS unsigned*)(lds + (bufoff) + ldsw + _i * 8192), 16, 0, 0); } while (0)
#define PG8_LDA(dst, b, h) do { _Pragma("unroll") for (int m = 0; m < 4; ++m) _Pragma("unroll") for (int k = 0; k < 2; ++k) dst[m][k] = *(const LAS bf16x8*)(lds + PG8_SA(b, h) + aoff + m * 2048 + k * 1024); } while (0)
#define PG8_TR1(dstv, n, k, b, h) do { bf16x4 _lo, _hi; \
            asm volatile("ds_read_b64_tr_b16 %0, %1 offset:%2" : "=v"(_lo) : "v"(tb[n][0]), "i"((((b) * 2 + (h)) * 16384 + (k) * 8192)) : "memory"); \
            asm volatile("ds_read_b64_tr_b16 %0, %1 offset:%2" : "=v"(_hi) : "v"(tb[n][1]), "i"((((b) * 2 + (h)) * 16384 + (k) * 8192)) : "memory"); \
            dstv = __builtin_shufflevector(_lo, _hi, 0, 1, 2, 3, 4, 5, 6, 7); } while (0)
#define PG8_LDB(dst, b, h) do { if constexpr (BMODE == 0) { _Pragma("unroll") for (int n = 0; n < 2; ++n) _Pragma("unroll") for (int k = 0; k < 2; ++k) dst[n][k] = *(const LAS bf16x8*)(lds + PG8_SB(b, h) + boff + n * 2048 + k * 1024); } \
        else { PG8_TR1(dst[0][0], 0, 0, b, h); PG8_TR1(dst[0][1], 0, 1, b, h); PG8_TR1(dst[1][0], 1, 0, b, h); PG8_TR1(dst[1][1], 1, 1, b, h); } } while (0)
#define PG8_MMA(ai, bj, At, Bt) do { __builtin_amdgcn_s_setprio(1); _Pragma("unroll") for (int m = 0; m < 4; ++m) _Pragma("unroll") for (int n = 0; n < 2; ++n) _Pragma("unroll") for (int k = 0; k < 2; ++k) \
        acc[ai][bj][m][n] = __builtin_amdgcn_mfma_f32_16x16x32_bf16(Bt[n][k], At[m][k], acc[ai][bj][m][n], 0, 0, 0); __builtin_amdgcn_s_setprio(0); } while (0)
#define PG8_STAGE_A2(bufoff, gbase, h) do { if (GATHER && last) PG8_STAGE(bufoff, gbase, vAn[h]); else PG8_STAGE(bufoff, gbase, vAc[h]); } while (0)
#define PG8_WAIT_V(n) asm volatile("s_waitcnt vmcnt(" #n ")" ::: "memory")
#define PG8_WAIT_L(n) asm volatile("s_waitcnt lgkmcnt(" #n ")" ::: "memory")
#define PG8_BAR __builtin_amdgcn_s_barrier()
#define PG8_SCHED __builtin_amdgcn_sched_barrier(0)
#define PG8_AOFF(u, v) do { const int _t = opaque_tid(); _Pragma("unroll") for (int _i = 0; _i < 2; ++_i) { int _R, _C; stage_rc(_t * 16 + _i * 8192, _R, _C); _Pragma("unroll") for (int _h = 0; _h < 2; ++_h) \
        (v)[_h][_i] = GATHER ? ((unsigned)S.row((u), _h * 128 + _R) * (unsigned)K + (unsigned)_C) * 2u : ((unsigned)(_h * 128 + _R) * (unsigned)K + (unsigned)_C) * 2u; } } while (0)
    GU cur, nxt; int ui = 0;
    if (!S.next(0, cur)) return;
    f32x4 acc[2][2][4][2];
#pragma unroll
    for (int a = 0; a < 2; ++a)
#pragma unroll
        for (int b = 0; b < 2; ++b)
#pragma unroll
            for (int m = 0; m < 4; ++m)
#pragma unroll
                for (int n = 0; n < 2; ++n) acc[a][b][m][n] = (f32x4){0.f, 0.f, 0.f, 0.f};
    bf16x8 At[4][2], B0[2][2], B1[2][2];
    PG8_AOFF(cur, vAc);
    if (GATHER) { VM_WAIT(); }
    const char* cA = cur.a; const char* cB0 = cur.b0; const char* cB1 = cur.b1;
    PG8_STAGE(PG8_SB(0, 0), cB0, voffB); PG8_STAGE(PG8_SB(0, 1), cB1, voffB); PG8_STAGE(PG8_SA(0, 0), cA, vAc[0]); PG8_STAGE(PG8_SA(0, 1), cA, vAc[1]);
    if (wr == 1) PG8_BAR;
    PG8_WAIT_V(2); PG8_BAR;
    PG8_STAGE(PG8_SB(1, 0), cB0 + kstepB, voffB); PG8_STAGE(PG8_SA(1, 0), cA + kstep, vAc[0]); PG8_STAGE(PG8_SB(1, 1), cB1 + kstepB, voffB);
    PG8_WAIT_V(6); PG8_BAR;
    for (;;) {
        const bool has_next = S.next(ui + 1, nxt);
        const bool skip0 = (cur.half >= 2) && (wr == 1);
        const char* nA = has_next ? nxt.a : cA; const char* nB0 = has_next ? nxt.b0 : cB0; const char* nB1 = has_next ? nxt.b1 : cB1;
        for (int t = 0; t < nt; t += 2) {
            const bool last = (t == nt - 2);
            const char* a1 = cA + (size_t)(t + 1) * kstep;
            const char* a2 = last ? nA : cA + (size_t)(t + 2) * kstep;
            const char* b20 = last ? nB0 : cB0 + (size_t)(t + 2) * kstepB; const char* b21 = last ? nB1 : cB1 + (size_t)(t + 2) * kstepB;
            const char* a3 = a2 + kstep; const char* b30 = b20 + kstepB; const char* b31 = b21 + kstepB;
            if (GATHER && last) { if (has_next) { PG8_AOFF(nxt, vAn); } else {
#pragma unroll
                for (int h = 0; h < 2; ++h)
#pragma unroll
                    for (int i = 0; i < 2; ++i) vAn[h][i] = vAc[h][i]; } }
            PG8_LDB(B0, 0, 0); PG8_LDB(B1, 0, 1); PG8_SCHED; PG8_LDA(At, 0, 0); PG8_STAGE(PG8_SA(1, 1), a1, vAc[1]);
            PG8_WAIT_V(8); PG8_WAIT_L(0); PG8_BAR; if (!skip0) { PG8_MMA(0, 0, At, B0); PG8_MMA(0, 1, At, B1); } PG8_BAR; PG8_SCHED;
            PG8_LDA(At, 0, 1); PG8_STAGE(PG8_SB(0, 0), b20, voffB); PG8_STAGE(PG8_SB(0, 1), b21, voffB); PG8_STAGE_A2(PG8_SA(0, 0), a2, 0);
            PG8_WAIT_V(8); PG8_WAIT_L(0); PG8_BAR; if (!cur.half) { PG8_MMA(1, 0, At, B0); PG8_MMA(1, 1, At, B1); } PG8_BAR; PG8_SCHED;
            PG8_LDB(B0, 1, 0); PG8_LDB(B1, 1, 1); PG8_SCHED; PG8_LDA(At, 1, 0); PG8_STAGE_A2(PG8_SA(0, 1), a2, 1);
            PG8_WAIT_V(8); PG8_WAIT_L(0); PG8_BAR; if (!skip0) { PG8_MMA(0, 0, At, B0); PG8_MMA(0, 1, At, B1); } PG8_BAR; PG8_SCHED;
            PG8_LDA(At, 1, 1); PG8_STAGE(PG8_SB(1, 0), b30, voffB); PG8_STAGE(PG8_SB(1, 1), b31, voffB); PG8_STAGE_A2(PG8_SA(1, 0), a3, 0);
            PG8_WAIT_V(8); PG8_WAIT_L(0); PG8_BAR; if (!cur.half) { PG8_MMA(1, 0, At, B0); PG8_MMA(1, 1, At, B1); } PG8_BAR; PG8_SCHED;
        }
        if (wr == 0) PG8_BAR;
        E(acc, cur, wr, wc, fr, fq);
        if (!has_next) break;
#pragma unroll
        for (int a = 0; a < 2; ++a)
#pragma unroll
            for (int b = 0; b < 2; ++b)
#pragma unroll
                for (int m = 0; m < 4; ++m)
#pragma unroll
                    for (int n = 0; n < 2; ++n) acc[a][b][m][n] = (f32x4){0.f, 0.f, 0.f, 0.f};
        cur = nxt; cA = nA; cB0 = nB0; cB1 = nB1; ++ui;
        if (GATHER) {
#pragma unroll
            for (int h = 0; h < 2; ++h)
#pragma unroll
                for (int i = 0; i < 2; ++i) vAc[h][i] = vAn[h][i]; }
        if (wr == 1) PG8_BAR;
    }
    PG8_WAIT_V(0);
    PG8_BAR;
#undef PG8_SA
#undef PG8_SB
#undef PG8_STAGE
#undef PG8_LDA
#undef PG8_LDB
#undef PG8_TR1
#undef PG8_MMA
#undef PG8_WAIT_V
#undef PG8_WAIT_L
#undef PG8_BAR
#undef PG8_SCHED
#undef PG8_AOFF
#undef PG8_STAGE_A2
}
}
struct Params {
    const float* x; const float* meta; const float* lbl; const float* nmw; const float* w_in; const float* hgnw; const float* mbi; const float* mbf; const float* mlnw;
    const float* cw; const float* cb; const float* dtb; const float* alog; const float* dsk; const float* ssnw; const float* w_out; const float* nfw; const float* wg; const float* bg;
    const float* wr; const float* br; const float* w1; const float* w3; const float* w2; const float* fnw;
    float* out; unsigned char* ws;
};
constexpr size_t MiB = 1u << 20;
constexpr size_t al256(size_t x) { return (x + 255) / 256 * 256; }
constexpr size_t WS_CTL = 0, CTL_BYTES = 65536;
constexpr int CW_BAR = 0;
constexpr int CW_CNT = 4096;
constexpr size_t WS_WTIN  = WS_CTL + CTL_BYTES;
constexpr int NPROJX = NPROJ + 256;
constexpr size_t WS_WGIN  = WS_WTIN + al256((size_t)DEPTH * D * D_IN * 2);
constexpr size_t WS_WTOUT = WS_WGIN + al256((size_t)DEPTH * NGATE * D * 4);
constexpr size_t WS_WRT   = WS_WTOUT + al256((size_t)DEPTH * D * D * 2);
constexpr size_t WRF_LAYER = (size_t)64 * 3 * 2 * 64 * 8;
constexpr size_t WS_H0    = WS_WRT + al256((size_t)DEPTH * WRF_LAYER * 2);
constexpr size_t WS_H1    = WS_H0 + al256((size_t)R * D * 4);
constexpr size_t WS_U     = WS_H1 + al256((size_t)R * D * 4);
constexpr size_t WS_PROJ  = WS_U + al256((size_t)R * D * 2);
constexpr size_t WS_GATES = WS_PROJ + al256((size_t)R * NPROJ * 2);
constexpr size_t WS_MIXED = WS_GATES + al256((size_t)R * NGATE * 4);
constexpr size_t WS_COMMON_END = WS_MIXED + al256((size_t)R * D * 2);
constexpr int LDS_BYTES = 147456;
constexpr int LDS_BARW = LDS_BYTES - 64;
constexpr int LDS_PARAMS = LDS_BYTES - 64 - 256;
constexpr int LDS_QSLOT = LDS_PARAMS + 8 * 28;
__device__ __forceinline__ const void* lds_ptr(LAS unsigned char* lds, int i) {
    const u32x2 w = *(const LAS u32x2*)(lds + LDS_PARAMS + 8 * i);
    const unsigned lo = __builtin_amdgcn_readfirstlane(w.x), hi = __builtin_amdgcn_readfirstlane(w.y);
    GAS const void* g = (GAS const void*)(((unsigned long long)hi << 32) | lo);
    return (const void*)g;
}
__device__ __forceinline__ void p0_stream_convert(const float* src, bf16_t* dst, size_t n8, size_t gt, size_t NGT) {
#pragma unroll 4
    for (size_t i = gt; i < n8; i += NGT) {
        const f32x4 a = __builtin_nontemporal_load((const f32x4*)(src + i * 8)), b = __builtin_nontemporal_load((const f32x4*)(src + i * 8 + 4));
        u32x4 o; o.x = cvt_pk_bf16(a.x, a.y); o.y = cvt_pk_bf16(a.z, a.w); o.z = cvt_pk_bf16(b.x, b.y); o.w = cvt_pk_bf16(b.z, b.w);
        *(u32x4*)(dst + i * 8) = o;
    }
}
__device__ __forceinline__ void phase_p0(const Params& p, LAS unsigned char* lds) {
    (void)lds;
    const int tid = opaque_tid();
    const size_t gt = (size_t)blockIdx.x * NTHREADS + tid, NGT = (size_t)gridDim.x * NTHREADS;
    p0_stream_convert(p.w_in, (bf16_t*)(p.ws + WS_WTIN), (size_t)DEPTH * D * D_IN / 8, gt, NGT);
    p0_stream_convert(p.w_out, (bf16_t*)(p.ws + WS_WTOUT), (size_t)DEPTH * D * D / 8, gt, NGT);
    bf16_t* wrf = (bf16_t*)(p.ws + WS_WRT);
    for (int i = (int)gt; i < DEPTH * 64 * 3 * 64; i += (int)NGT) {
        const int l = i / (64 * 3 * 64), ks = (i / (3 * 64)) % 64, ct = (i / 64) % 3, ln = i % 64;
        const int col = ct * 16 + (ln & 15);
        float hi[8], lo[8];
#pragma unroll
        for (int j = 0; j < 8; ++j) { const int k = ks * 32 + (ln >> 4) * 8 + j;
            float v = 0.f;
            if (col < 4) v = p.wg[((size_t)l * D + k) * 4 + col];
            else if (col < 36) { const int e = col - 4, g = e >> 3, ee = e & 7; v = p.wr[(((size_t)l * 4 + g) * D + k) * 8 + ee]; }
            v *= p.nfw[(size_t)l * D + k];
            hi[j] = bf2f(f2bf(v)); lo[j] = v - hi[j]; }
        bf16_t* dst = wrf + (size_t)l * WRF_LAYER + ((((size_t)ks * 3 + ct) * 2) * 64 + ln) * 8;
        *(u32x4*)dst = pack8(hi); *(u32x4*)(dst + 64 * 8) = pack8(lo);
    }
}

struct N1Src { const float* hsrc; int layer_prev; int pad; };
template <int MODE>
__device__ __forceinline__ void n1_load_row(const Params& p, const N1Src& s, int excl, int r, int lane, f32x4 (&v)[8]);
__device__ __forceinline__ int combine_excl(const Params& p, int layer, int lane);

#ifndef N1_NT
#define N1_NT 0
#endif
#if N1_NT
#define N1_ST(v, p) __builtin_nontemporal_store((v), (p))
#define N1_LD(p) __builtin_nontemporal_load(p)
#else
#define N1_ST(v, p) (*(p) = (v))
#define N1_LD(p) (*(p))
#endif
template <int MODE>
__device__ __forceinline__ void phase_n1(const Params& p, int layer, const N1Src& src) {
    const int tid = opaque_tid(), lane = tid & 63, wave = __builtin_amdgcn_readfirstlane(tid >> 6);
    const int gw = blockIdx.x * NWAVES + wave, NGW = gridDim.x * NWAVES;
    float* h0 = (float*)(p.ws + WS_H0); bf16_t* U = (bf16_t*)(p.ws + WS_U);
    const float* wn = p.nmw + (size_t)layer * D;
    f32x4 wv[8];
#pragma unroll
    for (int j = 0; j < 8; ++j) wv[j] = *(const f32x4*)(wn + 4 * lane + 256 * j);
    const int excl = (MODE == 2) ? combine_excl(p, src.layer_prev, lane) : 0;
    for (int task = gw; task < R / 2; task += NGW) {
        f32x4 v[2][8];
#pragma unroll
        for (int q = 0; q < 2; ++q) n1_load_row<MODE>(p, src, excl, 2 * task + q, lane, v[q]);
#pragma unroll
        for (int q = 0; q < 2; ++q) {
            const int r = 2 * task + q;
            float ss = 0.f;
#pragma unroll
            for (int j = 0; j < 8; ++j) { if (MODE != 0) N1_ST(v[q][j], (f32x4*)(h0 + (size_t)r * D + 4 * lane + 256 * j)); ss += (v[q][j].x * v[q][j].x + v[q][j].y * v[q][j].y) + (v[q][j].z * v[q][j].z + v[q][j].w * v[q][j].w); }
            const float rs = rsqrtf(wave_sum(ss) * (1.f / D) + EPS);
#pragma unroll
            for (int j = 0; j < 8; ++j) { v[q][j] = v[q][j] * rs * wv[j];
                u32x2 o; o.x = cvt_pk_bf16(v[q][j].x, v[q][j].y); o.y = cvt_pk_bf16(v[q][j].z, v[q][j].w);
                *(u32x2*)(U + (size_t)r * D + 4 * lane + 256 * j) = o; }
        }
    }
}
template <>
__device__ __forceinline__ void n1_load_row<0>(const Params& p, const N1Src&, int, int r, int lane, f32x4 (&v)[8]) {
    const int b = r / PB, pp = r % PB;
    if (pp < LEADP) {
#pragma unroll
        for (int j = 0; j < 8; ++j) v[j] = (f32x4){0.f, 0.f, 0.f, 0.f};
    } else {
        const int l = pp - LEADP;
        const float* s = l < NMETA ? p.meta + (size_t)l * D : p.x + ((size_t)b * SEQ + (l - NMETA)) * D;
#pragma unroll
        for (int j = 0; j < 8; ++j) v[j] = *(const f32x4*)(s + 4 * lane + 256 * j);
    }
}
template <>
__device__ __forceinline__ void n1_load_row<1>(const Params& p, const N1Src& sr, int, int r, int lane, f32x4 (&v)[8]) {
    const int b = r / PB, pp = r % PB;
    if (pp < LEADP) {
#pragma unroll
        for (int j = 0; j < 8; ++j) v[j] = (f32x4){0.f, 0.f, 0.f, 0.f};
    } else {
        const float* s = sr.hsrc + ((size_t)b * LTOK + (pp - LEADP)) * D;
#pragma unroll
        for (int j = 0; j < 8; ++j) v[j] = *(const f32x4*)(s + 4 * lane + 256 * j);
    }
}

struct SchedPlain {
    static constexpr int ldb = 0;
    pg8::TileOrder T; const char* A; const char* Bt; int K;
    __device__ bool next(int i, pg8::GU& u) const { int pm, pn; if (!T.tile(i, pm, pn)) return false;
        u.a = A + (size_t)pm * 256 * K * 2; u.b0 = Bt + (size_t)pn * 256 * K * 2; u.b1 = u.b0 + (size_t)128 * K * 2; u.r0 = pm * 256; u.c0 = pn * 256; u.ex = 0; u.half = 0; return true; }
    __device__ int row(const pg8::GU&, int) const { return 0; }
};
struct EpiBf16Store {
    static constexpr bool PERM = true;
    bf16_t* O; int ldc;
    __device__ __forceinline__ void operator()(const f32x4 (&acc)[2][2][4][2], const pg8::GU& u, int wr, int wc, int fr, int fq) const {
        const int row0 = u.r0 + wr * 64 + fr, col0 = u.c0 + wc * 32 + 8 * fq;
#pragma unroll
        for (int ai = 0; ai < 2; ++ai)
#pragma unroll
            for (int m = 0; m < 4; ++m) { bf16_t* rowp = O + (size_t)(row0 + ai * 128 + m * 16) * ldc + col0;
#pragma unroll
                for (int bj = 0; bj < 2; ++bj) { const f32x4 v0 = acc[ai][bj][m][0], v1 = acc[ai][bj][m][1];
                    u32x4 w; w.x = cvt_pk_bf16(v0[0], v0[1]); w.y = cvt_pk_bf16(v0[2], v0[3]); w.z = cvt_pk_bf16(v1[0], v1[1]); w.w = cvt_pk_bf16(v1[2], v1[3]);
                    *(u32x4*)(rowp + bj * 128) = w; } }
    }
};
#ifndef NT_EPI
#define NT_EPI 0
#endif
#if NT_EPI
#define NT_STORE(v, p) __builtin_nontemporal_store((v), (p))
#else
#define NT_STORE(v, p) (*(p) = (v))
#endif
struct SchedG1 {
    static constexpr int ldb = D_IN * 2;
    pg8::TileOrder T; const char* A; const char* W;
    __device__ bool next(int i, pg8::GU& u) const { int pm, pn; if (!T.tile(i, pm, pn)) return false;
        u.a = A + (size_t)pm * 256 * D * 2; u.r0 = pm * 256; u.c0 = pn * 256; u.ex = 0; u.half = 0;
        if (pn < NPROJ / 256) { const int sc = u.c0 < 3584 ? u.c0 : u.c0 + 8; u.b0 = W + (size_t)sc * 2; u.b1 = u.b0 + 256; }
        else { u.b0 = W + (size_t)3584 * 2; u.b1 = W + (size_t)6664 * 2; }
        return true; }
    __device__ int row(const pg8::GU&, int) const { return 0; }
};
struct EpiProj {
    static constexpr bool PERM = false;
    bf16_t* O; float* G;
    __device__ __forceinline__ void operator()(const f32x4 (&acc)[2][2][4][2], const pg8::GU& u, int wr, int wc, int fr, int fq) const {
        const int row0 = u.r0 + wr * 64 + fr;
        if (u.c0 < NPROJ) {
            const int col0 = u.c0 + wc * 32 + 4 * fq;
#pragma unroll
            for (int ai = 0; ai < 2; ++ai) if (ai == 0 || !u.half)
#pragma unroll
                for (int m = 0; m < 4; ++m) { bf16_t* rowp = O + (size_t)(row0 + ai * 128 + m * 16) * NPROJ + col0;
#pragma unroll
                    for (int bj = 0; bj < 2; ++bj)
#pragma unroll
                        for (int n = 0; n < 2; ++n) { const f32x4 v = acc[ai][bj][m][n]; u32x2 o; o.x = cvt_pk_bf16(v[0], v[1]); o.y = cvt_pk_bf16(v[2], v[3]); NT_STORE(o, (u32x2*)(rowp + bj * 128 + n * 16)); } }
        } else if (wc == 0) {
#pragma unroll
            for (int ai = 0; ai < 2; ++ai) if (ai == 0 || !u.half)
#pragma unroll
                for (int m = 0; m < 4; ++m) { float* gp = G + (size_t)(row0 + ai * 128 + m * 16) * NGATE;
                    if (fq < 2) *(f32x4*)(gp + 4 * fq) = acc[ai][0][m][0];
                    *(f32x4*)(gp + 8 + 4 * fq) = acc[ai][1][m][0]; }
        }
    }
};
__device__ __forceinline__ void phase_g1(const Params& p, int layer, LAS unsigned char* lds) {
    SchedG1 S; S.T.init(R / 256, NPROJX / 256, gridDim.x, blockIdx.x); S.A = (const char*)(p.ws + WS_U); S.W = (const char*)(p.ws + WS_WTIN) + (size_t)layer * D * D_IN * 2;
    EpiProj E{(bf16_t*)(p.ws + WS_PROJ), (float*)(p.ws + WS_GATES)};
    pg8::gemm_phase<EpiProj, SchedG1, false, 1>(lds, D, S, E);
}
constexpr size_t WS_ST_S  = WS_COMMON_END;
constexpr size_t WS_ST_M  = WS_ST_S + al256((size_t)NCH * 16 * 8192 * 2);
constexpr size_t WS_ST_H  = WS_ST_M + al256((size_t)NCH * 4 * 8192 * 2);
constexpr size_t WS_DEC_S = WS_ST_H + al256((size_t)NCH * 4 * 16384 * 2);
constexpr size_t WS_NV_M  = WS_DEC_S + al256((size_t)NCH * 16 * 4);
constexpr size_t WS_SC_M  = WS_NV_M + al256((size_t)NCH * 4 * 64 * 4);
constexpr size_t WS_DEC_H = WS_SC_M + al256((size_t)NCH * 4 * 2 * 4);
constexpr size_t WS_MP_M  = WS_DEC_H + al256((size_t)NCH * 4 * 128 * 4);
constexpr size_t WS_MIX_END = WS_MP_M + al256((size_t)NCH * 4 * 4);

__device__ __forceinline__ f32x4 mfma16(bf16x8 a, bf16x8 b, f32x4 c) { return __builtin_amdgcn_mfma_f32_16x16x32_bf16(a, b, c, 0, 0, 0); }
template <int P> __device__ __forceinline__ bf16x8 frag_row(LAS const unsigned char* base, int row0, int k0, int fr, int fq) {
    return *(const LAS bf16x8*)(base + (row0 + fr) * P + (k0 + 8 * fq) * 2);
}
template <int P> __device__ __forceinline__ bf16x8 frag_tr(LAS const unsigned char* base, int k0, int col0, int lane) {
    const int g = lane >> 4, q = (lane & 15) >> 2, pp = lane & 3;
    const unsigned a = (unsigned)(size_t)base + (unsigned)((k0 + 8 * g + q) * P + (col0 + 4 * pp) * 2);
    bf16x4 lo, hi;
    asm volatile("ds_read_b64_tr_b16 %0, %2\n\tds_read_b64_tr_b16 %1, %2 offset:%3\n\ts_waitcnt lgkmcnt(0)" : "=&v"(lo), "=&v"(hi) : "v"(a), "i"(4 * P) : "memory");
    bf16x8 r; r[0] = lo[0]; r[1] = lo[1]; r[2] = lo[2]; r[3] = lo[3]; r[4] = hi[0]; r[5] = hi[1]; r[6] = hi[2]; r[7] = hi[3];
    return r;
}
__device__ __forceinline__ float wave_scan_incl(float v, int lane) {
#pragma unroll
    for (int o = 1; o < 64; o <<= 1) { const float t = __shfl_up(v, o); if (lane >= o) v += t; }
    return v;
}
__device__ __forceinline__ float wave_scan_max_incl(float v, int lane) {
#pragma unroll
    for (int o = 1; o < 64; o <<= 1) { const float t = __shfl_up(v, o); if (lane >= o) v = fmaxf(v, t); }
    return v;
}
__device__ __forceinline__ float wave_max(float v) {
#pragma unroll
    for (int o = 1; o < 64; o <<= 1) v = fmaxf(v, __shfl_xor(v, o));
    return v;
}
template <int KS> __device__ __forceinline__ int frag_off4(int n, int kbase) {
    return (((n >> 4) * KS + (kbase >> 5)) * 64 + ((kbase & 31) >> 3) * 16 + (n & 15)) * 8 + (kbase & 7);
}

#ifndef SCAN_NT
#define SCAN_NT 0
#endif
#if SCAN_NT
#define SCAN_LD(p) __builtin_nontemporal_load(p)
#else
#define SCAN_LD(p) (*(p))
#endif
#ifndef PROBE_D
#define PROBE_D d
#endif
#ifndef PROBE_L
#define PROBE_L 1.f
#endif
#ifndef SSD_RPT_CONV
#define SSD_RPT_CONV 1
#endif
#ifndef SSD_RPT_S3
#define SSD_RPT_S3 1
#endif
#ifndef SSD_RPT_S4
#define SSD_RPT_S4 1
#endif
#ifndef SSD_RPT_EPI
#define SSD_RPT_EPI 1
#endif
#ifndef SSD_RPT_GATES
#define SSD_RPT_GATES 1
#endif
namespace ssd {
constexpr int PC = 272, PX = 528, PM = 144;
constexpr int OFF_C = 0, OFF_B = 64 * PC, OFF_X = OFF_B + 64 * PC, OFF_M = OFF_X + 64 * PX, OFF_CUM = OFF_M + 4 * 64 * PM, OFF_END = OFF_CUM + 3 * 4 * 64 * 4;
constexpr int PY = 260;
static_assert(OFF_B + 64 * PY * 4 <= OFF_CUM, "Y staging overlays B, X, M");

__device__ __forceinline__ void gates(const Params& p, int layer, LAS unsigned char* lds, int c, int g, bool phaseA) {
    const int tid = opaque_tid(), lane = tid & 63, wave = __builtin_amdgcn_readfirstlane(tid >> 6);
    LAS float* cum = (LAS float*)(lds + OFF_CUM); LAS float* dtv = cum + 256; LAS float* wend = cum + 512;
    if (wave < 4) {
        const int hd = 4 * g + wave, row = c * 64 + lane, pp = row % PB;
        const float* gates = (const float*)(p.ws + WS_GATES);
        float dt = 0.f;
        if (pp >= LEADP) dt = softplusf_(gates[(size_t)row * NGATE + 8 + hd] + p.dtb[layer * 16 + hd]);
        const float a = -__expf(p.alog[layer * 16 + hd]);
        const float cs = wave_scan_incl(dt * a, lane);
        const float last = __shfl(cs, 63);
        cum[wave * 64 + lane] = cs; dtv[wave * 64 + lane] = dt; wend[wave * 64 + lane] = __expf(last - cs);
        if (phaseA && lane == 0) ((float*)(p.ws + WS_DEC_S))[c * 16 + hd] = __expf(last);
    }
}
struct ConvRegs { u32x4 raw[11]; f32x4 w[4][2]; f32x4 b[2]; };
__device__ __forceinline__ void conv_load(const Params& p, int layer, int c, int g, int ncg, ConvRegs& Rg) {
    const int tid = opaque_tid(), cg = tid & 63, rb = tid >> 6;
    const int cgc = cg < ncg ? cg : 0;
    const int n = c % CPB;
    const int ci = cgc < 32 ? g * 256 + cgc * 8 : (cgc < 48 ? 1024 + g * 128 + (cgc - 32) * 8 : 1536 + g * 128 + (cgc - 48) * 8);
    const float* cw = p.cw + (size_t)layer * 4 * 2048 + ci; const float* cb = p.cb + (size_t)layer * 2048 + ci;
#pragma unroll
    for (int t = 0; t < 4; ++t) { Rg.w[t][0] = *(const f32x4*)(cw + t * 2048); Rg.w[t][1] = *(const f32x4*)(cw + t * 2048 + 4); }
    Rg.b[0] = *(const f32x4*)cb; Rg.b[1] = *(const f32x4*)(cb + 4);
    const bf16_t* src = (const bf16_t*)(p.ws + WS_PROJ) + (size_t)(c * 64) * NPROJ + P_SX + ci;
#pragma unroll
    for (int i = 0; i < 11; ++i) { const int s = rb * 8 - 3 + i;
        if (s < 0 && n == 0) Rg.raw[i] = (u32x4){0u, 0u, 0u, 0u}; else Rg.raw[i] = *(const u32x4*)(src + (ptrdiff_t)s * NPROJ); }
}
__device__ __forceinline__ void conv_compute(LAS unsigned char* lds, int ncg, LAS const float* xs0, LAS const float* xs1, const ConvRegs& Rg, bf16_t* gdst, int gch) {
    const int tid = opaque_tid(), cg = tid & 63, rb = tid >> 6;
    if (cg >= ncg) return;
    int loff, pitch;
    if (cg < 32) { loff = OFF_X + cg * 16; pitch = PX; } else if (cg < 48) { loff = OFF_B + (cg - 32) * 16; pitch = PC; } else { loff = OFF_C + (cg - 48) * 16; pitch = PC; }
    const float w[4][8] = {{Rg.w[0][0].x, Rg.w[0][0].y, Rg.w[0][0].z, Rg.w[0][0].w, Rg.w[0][1].x, Rg.w[0][1].y, Rg.w[0][1].z, Rg.w[0][1].w},
                           {Rg.w[1][0].x, Rg.w[1][0].y, Rg.w[1][0].z, Rg.w[1][0].w, Rg.w[1][1].x, Rg.w[1][1].y, Rg.w[1][1].z, Rg.w[1][1].w},
                           {Rg.w[2][0].x, Rg.w[2][0].y, Rg.w[2][0].z, Rg.w[2][0].w, Rg.w[2][1].x, Rg.w[2][1].y, Rg.w[2][1].z, Rg.w[2][1].w},
                           {Rg.w[3][0].x, Rg.w[3][0].y, Rg.w[3][0].z, Rg.w[3][0].w, Rg.w[3][1].x, Rg.w[3][1].y, Rg.w[3][1].z, Rg.w[3][1].w}};
    const float bias[8] = {Rg.b[0].x, Rg.b[0].y, Rg.b[0].z, Rg.b[0].w, Rg.b[1].x, Rg.b[1].y, Rg.b[1].z, Rg.b[1].w};
    const int hd = cg >> 3;
    float r0[8], r1[8], r2[8], r3[8];
    unpack8(Rg.raw[0], r0); unpack8(Rg.raw[1], r1); unpack8(Rg.raw[2], r2);
#pragma unroll
    for (int i = 0; i < 8; ++i) {
        const int s = rb * 8 + i;
        unpack8(Rg.raw[3 + i], r3);
        float o[8];
        float sc = 1.f, sc2 = 1.f;
        if (cg < 32) { sc = xs0[hd * 64 + s]; if (xs1) sc2 = xs1[hd * 64 + s]; }
#pragma unroll
        for (int j = 0; j < 8; ++j) { const float a = bias[j] + w[0][j] * r0[j] + w[1][j] * r1[j] + w[2][j] * r2[j] + w[3][j] * r3[j]; o[j] = siluf_(a) * sc; }
        if (gdst) *(u32x4*)(gdst + (size_t)s * D + gch) = pack8(o);
        if (cg < 48) {
#pragma unroll
            for (int j = 0; j < 8; ++j) o[j] *= sc2;
            *(LAS u32x4*)(lds + loff + s * pitch) = pack8(o); }
#pragma unroll
        for (int j = 0; j < 8; ++j) { r0[j] = r1[j]; r1[j] = r2[j]; r2[j] = r3[j]; }
    }
}

__device__ __forceinline__ void phase_a(const Params& p, int layer, LAS unsigned char* lds, int c, int g) {
    const int tid = opaque_tid(), lane = tid & 63, wave = __builtin_amdgcn_readfirstlane(tid >> 6), fr = lane & 15, fq = lane >> 4;
    LAS float* cum = (LAS float*)(lds + OFF_CUM); LAS float* dtv = cum + 256; LAS float* wend = cum + 512;
    ConvRegs Rg; conv_load(p, layer, c, g, 64, Rg);
    gates(p, layer, lds, c, g, true);
    __syncthreads();
    { const int cg = tid & 63; const int ci = cg < 32 ? g * 256 + cg * 8 : (cg < 48 ? 1024 + g * 128 + (cg - 32) * 8 : 1536 + g * 128 + (cg - 48) * 8);
      conv_compute(lds, 64, dtv, wend, Rg, (bf16_t*)(p.ws + WS_U) + (size_t)(c * 64) * D, ci); }
    __syncthreads();
#ifdef PROBE_REFA
    for (int e = tid; e < 4 * 64 * 128; e += NTHREADS) {
        const int hh = e >> 13, pp_ = (e >> 7) & 63, k = e & 127;
        float a = 0.f;
        for (int s = 0; s < 64; ++s) a += bf2f(*(LAS bf16_t*)(lds + OFF_X + s * PX + (hh * 64 + pp_) * 2)) * bf2f(*(LAS bf16_t*)(lds + OFF_B + s * PC + k * 2));
        bf16_t* st2 = (bf16_t*)(p.ws + WS_ST_S) + ((size_t)c * 16 + 4 * g + hh) * 8192;
        st2[(((pp_ >> 4) * 4 + (k >> 5)) * 64 + ((k & 31) >> 3) * 16 + (pp_ & 15)) * 8 + (k & 7)] = f2bf(a);
    }
    __syncthreads();
    return;
#endif
    const int hd = wave >> 1;
    bf16_t* st = (bf16_t*)(p.ws + WS_ST_S) + ((size_t)c * 16 + 4 * g + hd) * 8192;
    bf16x8 xb[4][2];
#pragma unroll
    for (int pt = 0; pt < 4; ++pt)
#pragma unroll
        for (int ks = 0; ks < 2; ++ks) xb[pt][ks] = frag_tr<PX>(lds + OFF_X, ks * 32, hd * 64 + pt * 16, lane);
#pragma unroll
    for (int kk = 0; kk < 4; ++kk) {
        const int kt = 4 * (wave & 1) + kk;
        bf16x8 ba[2];
#pragma unroll
        for (int ks = 0; ks < 2; ++ks) ba[ks] = frag_tr<PC>(lds + OFF_B, ks * 32, kt * 16, lane);
#pragma unroll
        for (int pt = 0; pt < 4; ++pt) {
            f32x4 acc = (f32x4){0.f, 0.f, 0.f, 0.f};
#pragma unroll
            for (int ks = 0; ks < 2; ++ks) acc = mfma16(ba[ks], xb[pt][ks], acc);
            u32x2 o; o.x = cvt_pk_bf16(acc[0], acc[1]); o.y = cvt_pk_bf16(acc[2], acc[3]);
            *(u32x2*)(st + frag_off4<4>(pt * 16 + fr, kt * 16 + 4 * fq)) = o;
        }
    }
    __syncthreads();
}

__device__ __forceinline__ void phase_c(const Params& p, int layer, LAS unsigned char* lds, int c, int g) {
    const int tid = opaque_tid(), lane = tid & 63, wave = __builtin_amdgcn_readfirstlane(tid >> 6), fr = lane & 15, fq = lane >> 4;
    LAS float* cum = (LAS float*)(lds + OFF_CUM); LAS float* dtv = cum + 256;
    u32x4 xr[8];
    { const int cg = tid & 63, rb = tid >> 6; const int ci = cg < 32 ? g * 256 + cg * 8 : (cg < 48 ? 1024 + g * 128 + (cg - 32) * 8 : 1536 + g * 128 + (cg - 48) * 8);
      const bf16_t* xa = (const bf16_t*)(p.ws + WS_U) + (size_t)(c * 64 + rb * 8) * D + ci;
#pragma unroll
      for (int i = 0; i < 8; ++i) xr[i] = *(const u32x4*)(xa + (size_t)i * D); }
    const int hd = wave >> 1;
    bf16x8 sf[2][4];
    { const bf16_t* st = (const bf16_t*)(p.ws + WS_ST_S) + ((size_t)c * 16 + 4 * g + hd) * 8192;
#pragma unroll
      for (int pi = 0; pi < 2; ++pi)
#pragma unroll
          for (int ks = 0; ks < 4; ++ks) sf[pi][ks] = *(const bf16x8*)(st + (((2 * (wave & 1) + pi) * 4 + ks) * 64 + lane) * 8); }
    const bf16_t* proj = (const bf16_t*)(p.ws + WS_PROJ);
    u32x4 zr[4];
#pragma unroll
    for (int it = 0; it < 4; ++it) { const int item = it * 512 + tid; zr[it] = *(const u32x4*)(proj + (size_t)(c * 64 + (item >> 5)) * NPROJ + P_SZ + g * 256 + (item & 31) * 8); }
    const float* nw = p.ssnw + (size_t)layer * 1024 + g * 256 + (tid & 31) * 8;
    const f32x4 nw0 = *(const f32x4*)nw, nw1 = *(const f32x4*)(nw + 4);
    gates(p, layer, lds, c, g, false);
    { const int cg = tid & 63, rb = tid >> 6; int loff, pitch;
      if (cg < 32) { loff = OFF_X + cg * 16; pitch = PX; } else if (cg < 48) { loff = OFF_B + (cg - 32) * 16; pitch = PC; } else { loff = OFF_C + (cg - 48) * 16; pitch = PC; }
#pragma unroll
      for (int i = 0; i < 8; ++i) *(LAS u32x4*)(lds + loff + (rb * 8 + i) * pitch) = xr[i]; }
    __syncthreads();
    for (int rp_ = 0; rp_ < SSD_RPT_S3; ++rp_)
    for (int ti = wave; ti < 12; ti += 8) {
        int tt, st; bool zero = false;
        if (ti < 10) { tt = ti < 1 ? 0 : ti < 3 ? 1 : ti < 6 ? 2 : 3; st = ti - (tt * (tt + 1)) / 2; }
        else { zero = true; tt = ti == 10 ? 0 : 2; st = tt + 1; }
        f32x4 acc = (f32x4){0.f, 0.f, 0.f, 0.f};
        if (!zero) {
#pragma unroll
            for (int ks = 0; ks < 4; ++ks) acc = mfma16(frag_row<PC>(lds + OFF_C, tt * 16, ks * 32, fr, fq), frag_row<PC>(lds + OFF_B, st * 16, ks * 32, fr, fq), acc);
        }
        const int s = st * 16 + fr, t0 = tt * 16 + 4 * fq;
        const bool diag = (tt == st);
#pragma unroll
        for (int hd = 0; hd < 4; ++hd) {
            const float cs = cum[hd * 64 + s];
            const f32x4 ct4 = *(const LAS f32x4*)(cum + hd * 64 + t0);
            f32x4 tm4 = (f32x4){0.f, 0.f, 0.f, 0.f};
            if (diag) { const f32x4 d4 = *(const LAS f32x4*)(dtv + hd * 64 + t0); const float dsk = p.dsk[layer * 16 + 4 * g + hd];
#pragma unroll
                for (int r = 0; r < 4; ++r) tm4[r] = d4[r] > 0.f ? dsk * __builtin_amdgcn_rcpf(d4[r]) : 0.f; }
#pragma unroll
            for (int r = 0; r < 4; ++r) {
                const int t = t0 + r;
                float v = acc[r] * __expf(ct4[r] - cs);
                v = (!zero && s <= t) ? v : 0.f;
                v += (diag && s == t) ? tm4[r] : 0.f;
                *(LAS bf16_t*)(lds + OFF_M + hd * 64 * PM + t * PM + s * 2) = f2bf(v);
            }
        }
    }
    __syncthreads();
    f32x4 y[2][4];
    for (int rp_ = 0; rp_ < SSD_RPT_S4; ++rp_)
    {
        bf16x8 xf[2][2];
#pragma unroll
        for (int pi = 0; pi < 2; ++pi) { const int pt = 2 * (wave & 1) + pi;
#pragma unroll
            for (int ks = 0; ks < 2; ++ks) xf[pi][ks] = frag_tr<PX>(lds + OFF_X, ks * 32, hd * 64 + pt * 16, lane); }
#pragma unroll
        for (int tt = 0; tt < 4; ++tt) {
            bf16x8 cf[4], mf[2];
#pragma unroll
            for (int ks = 0; ks < 4; ++ks) cf[ks] = frag_row<PC>(lds + OFF_C, tt * 16, ks * 32, fr, fq);
#pragma unroll
            for (int ks = 0; ks < 2; ++ks) mf[ks] = frag_row<PM>(lds + OFF_M + hd * 64 * PM, tt * 16, ks * 32, fr, fq);
            float ec[4];
#pragma unroll
            for (int r = 0; r < 4; ++r) ec[r] = __expf(cum[hd * 64 + tt * 16 + 4 * fq + r]);
#pragma unroll
            for (int pi = 0; pi < 2; ++pi) {
                f32x4 acc = (f32x4){0.f, 0.f, 0.f, 0.f};
#pragma unroll
                for (int ks = 0; ks < 4; ++ks) acc = mfma16(cf[ks], sf[pi][ks], acc);
#pragma unroll
                for (int r = 0; r < 4; ++r) acc[r] *= ec[r];
#ifdef PROBE_NOOFF
                acc = (f32x4){0.f, 0.f, 0.f, 0.f};
#endif
#ifndef PROBE_NODIAG
                acc = mfma16(mf[0], xf[pi][0], acc);
                if (tt >= 2) acc = mfma16(mf[1], xf[pi][1], acc);
#endif
                y[pi][tt] = acc;
            }
        }
    }
    __syncthreads();
    LAS float* Y = (LAS float*)(lds + OFF_B);
#pragma unroll
    for (int pi = 0; pi < 2; ++pi)
#pragma unroll
        for (int tt = 0; tt < 4; ++tt)
#pragma unroll
            for (int r = 0; r < 4; ++r) Y[(tt * 16 + 4 * fq + r) * PY + hd * 64 + (2 * (wave & 1) + pi) * 16 + fr] = y[pi][tt][r];
    __syncthreads();
    bf16_t* mixed = (bf16_t*)(p.ws + WS_MIXED);
    for (int rp_ = 0; rp_ < SSD_RPT_EPI; ++rp_)
#pragma unroll
    for (int it = 0; it < 4; ++it) {
        const int item = it * 512 + tid, rloc = item >> 5, cgp = item & 31, row = c * 64 + rloc;
        float z[8], v[8];
        unpack8(zr[it], z);
        float ss = 0.f;
#pragma unroll
        for (int j = 0; j < 8; ++j) { v[j] = Y[rloc * PY + cgp * 8 + j] * siluf_(z[j]); ss += v[j] * v[j]; }
        ss = sum32_dpp(ss, lane);
        const float rs = rsqrtf(ss * (1.f / 256.f) + EPS);
        const f32x4 w0 = nw0, w1 = nw1;
        v[0] *= rs * w0.x; v[1] *= rs * w0.y; v[2] *= rs * w0.z; v[3] *= rs * w0.w; v[4] *= rs * w1.x; v[5] *= rs * w1.y; v[6] *= rs * w1.z; v[7] *= rs * w1.w;
#ifdef PROBE_ZERO
        for (int j = 0; j < 8; ++j) v[j] = 0.f;
#endif
        *(u32x4*)(mixed + (size_t)row * D + 1024 + g * 256 + cgp * 8) = pack8(v);
    }
    __syncthreads();
}

__device__ __forceinline__ void scan_item(const Params& p, int item) {
    const int e8 = item & 1023, bh = __builtin_amdgcn_readfirstlane(item >> 10), b = bh >> 4, hd = bh & 15;
    bf16_t* base = (bf16_t*)(p.ws + WS_ST_S) + ((size_t)(b * CPB) * 16 + hd) * 8192 + e8 * 8;
    const float* dec = (const float*)(p.ws + WS_DEC_S) + (b * CPB) * 16 + hd;
    u32x4 loc[CPB];
#pragma unroll
    for (int n = 0; n < CPB; ++n) loc[n] = SCAN_LD((const u32x4*)(base + (size_t)n * 16 * 8192));
    float S[8];
#pragma unroll
    for (int j = 0; j < 8; ++j) S[j] = 0.f;
#pragma unroll
    for (int n = 0; n < CPB; ++n) {
        const float d = dec[n * 16];
        float l[8]; unpack8(loc[n], l);
        *(u32x4*)(base + (size_t)n * 16 * 8192) = pack8(S);
#pragma unroll
        for (int j = 0; j < 8; ++j) S[j] = d * S[j] + l[j];
    }
}
}
namespace mls {
constexpr int PQ = 144, PV = 304, PP = 144;
constexpr int OFF_Q = 0, OFF_K = 64 * PQ, OFF_V = OFF_K + 64 * PQ, OFF_P = OFF_V + 64 * PV, OFF_G = OFF_P + 64 * PP, OFF_END = OFF_G + 6 * 64 * 4;
constexpr int PY = 148;
constexpr int OFF_Y = OFF_END;
constexpr float NEGV = -1e30f;

__device__ __forceinline__ void gates(const Params& p, int layer, LAS unsigned char* lds, int c, int h, bool phaseA) {
    const int tid = opaque_tid(), lane = tid & 63, wave = __builtin_amdgcn_readfirstlane(tid >> 6);
    LAS float* G = (LAS float*)(lds + OFF_G);
    if (wave == 0) {
        const int row = c * 64 + lane, pp = row % PB;
        const float* gates = (const float*)(p.ws + WS_GATES);
        float li = NEGV, lf = 0.f;
        if (pp >= LEADP) {
            const float ip = gates[(size_t)row * NGATE + h] + p.mbi[layer * 4 + h], fp = gates[(size_t)row * NGATE + 4 + h] + p.mbf[layer * 4 + h];
            li = 15.f * tanhf(ip * (1.f / 15.f)); lf = logsigmoidf_(15.f * tanhf(fp * (1.f / 15.f)));
        }
        const float cs = wave_scan_incl(lf, lane);
        const float last = __shfl(cs, 63);
        G[lane] = li; G[64 + lane] = cs;
        if (phaseA) {
            const float te = last - cs + li;
            const float ml = wave_max(te);
            G[128 + lane] = __expf(te - ml);
            if (lane == 0) { float* sc = (float*)(p.ws + WS_SC_M) + ((size_t)c * 4 + h) * 2; sc[0] = ml; sc[1] = last; }
        } else {
            const float mprev = ((const float*)(p.ws + WS_MP_M))[(size_t)c * 4 + h];
            const float mintra = cs + wave_scan_max_incl(li - cs, lane);
            const float inter = cs + mprev;
            const float mt = fmaxf(inter, mintra);
            G[128 + lane] = mt; G[192 + lane] = __expf(inter - mt); G[256 + lane] = __expf(-mt);
        }
    }
}

__device__ __forceinline__ void phase_a(const Params& p, int layer, LAS unsigned char* lds, int c, int h) {
    const int tid = opaque_tid(), lane = tid & 63, wave = __builtin_amdgcn_readfirstlane(tid >> 6), fr = lane & 15, fq = lane >> 4;
    LAS float* G = (LAS float*)(lds + OFF_G);
    const bf16_t* proj = (const bf16_t*)(p.ws + WS_PROJ) + (size_t)(c * 64) * NPROJ;
    const u32x4 kraw = *(const u32x4*)(proj + (size_t)(tid >> 3) * NPROJ + P_MK + h * 64 + (tid & 7) * 8);
    u32x4 vraw[2];
#pragma unroll
    for (int it = 0; it < 2; ++it) { const int item = it * 512 + tid; vraw[it] = *(const u32x4*)(proj + (size_t)(item >> 4) * NPROJ + P_MV + h * 128 + (item & 15) * 8); }
    gates(p, layer, lds, c, h, true);
    __syncthreads();
    {
        { const int s = tid >> 3, ch = tid & 7; float f[8]; unpack8(kraw, f); const float w = G[128 + s];
#pragma unroll
          for (int j = 0; j < 8; ++j) f[j] *= w;
          *(LAS u32x4*)(lds + OFF_K + s * PQ + ch * 16) = pack8(f); }
#pragma unroll
        for (int it = 0; it < 2; ++it) { const int item = it * 512 + tid; *(LAS u32x4*)(lds + OFF_V + (item >> 4) * PV + (item & 15) * 16) = vraw[it]; }
    }
    __syncthreads();
    bf16_t* st = (bf16_t*)(p.ws + WS_ST_M) + ((size_t)c * 4 + h) * 8192;
    {
        const int et = wave;
        bf16x8 vb[2];
#pragma unroll
        for (int ks = 0; ks < 2; ++ks) vb[ks] = frag_tr<PV>(lds + OFF_V, ks * 32, et * 16, lane);
#pragma unroll
        for (int dt = 0; dt < 4; ++dt) {
            f32x4 acc = (f32x4){0.f, 0.f, 0.f, 0.f};
#pragma unroll
            for (int ks = 0; ks < 2; ++ks) acc = mfma16(frag_tr<PQ>(lds + OFF_K, ks * 32, dt * 16, lane), vb[ks], acc);
            u32x2 o; o.x = cvt_pk_bf16(acc[0], acc[1]); o.y = cvt_pk_bf16(acc[2], acc[3]);
            *(u32x2*)(st + frag_off4<2>(et * 16 + fr, dt * 16 + 4 * fq)) = o;
        }
    }
    if (tid < 64) {
        float s = 0.f;
        for (int r = 0; r < 64; ++r) s += bf2f(*(LAS bf16_t*)(lds + OFF_K + r * PQ + tid * 2));
        ((float*)(p.ws + WS_NV_M))[((size_t)c * 4 + h) * 64 + tid] = s;
    }
    __syncthreads();
}

__device__ __forceinline__ void phase_c(const Params& p, int layer, LAS unsigned char* lds, int c, int h) {
    const int tid = opaque_tid(), lane = tid & 63, wave = __builtin_amdgcn_readfirstlane(tid >> 6), fr = lane & 15, fq = lane >> 4;
    LAS float* G = (LAS float*)(lds + OFF_G);
    const bf16_t* proj = (const bf16_t*)(p.ws + WS_PROJ) + (size_t)(c * 64) * NPROJ;
    const int ch = tid & 31, srow = tid >> 5;
    const int col = ch < 8 ? P_MQ + h * 64 + ch * 8 : (ch < 16 ? P_MK + h * 64 + (ch - 8) * 8 : P_MV + h * 128 + (ch - 16) * 8);
    u32x4 raw[4], og[2];
#pragma unroll
    for (int it = 0; it < 4; ++it) raw[it] = *(const u32x4*)(proj + (size_t)(it * 16 + srow) * NPROJ + col);
#pragma unroll
    for (int it = 0; it < 2; ++it) { const int item = it * 512 + tid; og[it] = *(const u32x4*)(proj + (size_t)(item >> 4) * NPROJ + P_MO + h * 128 + (item & 15) * 8); }
    const bf16_t* st = (const bf16_t*)(p.ws + WS_ST_M) + ((size_t)c * 4 + h) * 8192;
    bf16x8 cf[2];
#pragma unroll
    for (int ks = 0; ks < 2; ++ks) cf[ks] = *(const bf16x8*)(st + ((wave * 2 + ks) * 64 + lane) * 8);
    const float* nw = p.mlnw + (size_t)layer * 512 + h * 128 + (tid & 15) * 8;
    const f32x4 nw0 = *(const f32x4*)nw, nw1 = *(const f32x4*)(nw + 4);
    float npv = 0.f; if (tid < 64) npv = ((const float*)(p.ws + WS_NV_M))[((size_t)c * 4 + h) * 64 + tid];
    gates(p, layer, lds, c, h, false);
    {
        if (tid < 64) G[320 + tid] = npv;
        const int loff = ch < 8 ? OFF_Q + ch * 16 : (ch < 16 ? OFF_K + (ch - 8) * 16 : OFF_V + (ch - 16) * 16), pitch = ch < 16 ? PQ : PV;
#pragma unroll
        for (int it = 0; it < 4; ++it) { u32x4 w = raw[it];
            if (ch < 8) { float f[8]; unpack8(w, f);
#pragma unroll
                for (int j = 0; j < 8; ++j) f[j] *= 0.125f;
                w = pack8(f); }
            *(LAS u32x4*)(lds + loff + (it * 16 + srow) * pitch) = w; }
        if (tid < 128) { u32x4 o; o.x = (tid & 1) ? 0u : 0x00003f80u; o.y = 0u; o.z = 0u; o.w = 0u; *(LAS u32x4*)(lds + OFF_V + (tid >> 1) * PV + 256 + (tid & 1) * 16) = o; }
    }
    __syncthreads();
    for (int ti = wave; ti < 12; ti += 8) {
        int tt, st; bool zero = false;
        if (ti < 10) { tt = ti < 1 ? 0 : ti < 3 ? 1 : ti < 6 ? 2 : 3; st = ti - (tt * (tt + 1)) / 2; }
        else { zero = true; tt = ti == 10 ? 0 : 2; st = tt + 1; }
        f32x4 acc = (f32x4){0.f, 0.f, 0.f, 0.f};
        if (!zero) {
#pragma unroll
            for (int ks = 0; ks < 2; ++ks) acc = mfma16(frag_row<PQ>(lds + OFF_Q, tt * 16, ks * 32, fr, fq), frag_row<PQ>(lds + OFF_K, st * 16, ks * 32, fr, fq), acc);
        }
        const int s = st * 16 + fr, t0 = tt * 16 + 4 * fq;
        const float gs = G[s] - G[64 + s];
        const f32x4 ct4 = *(const LAS f32x4*)(G + 64 + t0), mt4 = *(const LAS f32x4*)(G + 128 + t0);
#pragma unroll
        for (int r = 0; r < 4; ++r) {
            const int t = t0 + r;
            float v = acc[r] * __expf(ct4[r] + gs - mt4[r]);
            v = (!zero && s <= t) ? v : 0.f;
            *(LAS bf16_t*)(lds + OFF_P + t * PP + s * 2) = f2bf(v);
        }
    }
    __syncthreads();
    f32x4 y[4], yd = (f32x4){0.f, 0.f, 0.f, 0.f};
    {
        bf16x8 vf[2];
#pragma unroll
        for (int ks = 0; ks < 2; ++ks) vf[ks] = frag_tr<PV>(lds + OFF_V, ks * 32, wave * 16, lane);
#pragma unroll
        for (int tt = 0; tt < 4; ++tt) {
            f32x4 acc = (f32x4){0.f, 0.f, 0.f, 0.f};
#pragma unroll
            for (int ks = 0; ks < 2; ++ks) acc = mfma16(frag_row<PQ>(lds + OFF_Q, tt * 16, ks * 32, fr, fq), cf[ks], acc);
#pragma unroll
            for (int r = 0; r < 4; ++r) acc[r] *= G[192 + tt * 16 + 4 * fq + r];
            acc = mfma16(frag_row<PP>(lds + OFF_P, tt * 16, 0, fr, fq), vf[0], acc);
            if (tt >= 2) acc = mfma16(frag_row<PP>(lds + OFF_P, tt * 16, 32, fr, fq), vf[1], acc);
            y[tt] = acc;
        }
        if (wave < 4) {
            const int tt = wave;
            bf16x8 nf[2], of[2];
#pragma unroll
            for (int ks = 0; ks < 2; ++ks) {
                float f[8];
#pragma unroll
                for (int j = 0; j < 8; ++j) f[j] = (fr == 0) ? G[320 + ks * 32 + 8 * fq + j] : 0.f;
                const u32x4 w = pack8(f); nf[ks] = __builtin_bit_cast(bf16x8, w);
                of[ks] = frag_tr<PV>(lds + OFF_V, ks * 32, 128, lane);
            }
            f32x4 acc = (f32x4){0.f, 0.f, 0.f, 0.f};
#pragma unroll
            for (int ks = 0; ks < 2; ++ks) acc = mfma16(frag_row<PQ>(lds + OFF_Q, tt * 16, ks * 32, fr, fq), nf[ks], acc);
#pragma unroll
            for (int r = 0; r < 4; ++r) acc[r] *= G[192 + tt * 16 + 4 * fq + r];
            acc = mfma16(frag_row<PP>(lds + OFF_P, tt * 16, 0, fr, fq), of[0], acc);
            if (tt >= 2) acc = mfma16(frag_row<PP>(lds + OFF_P, tt * 16, 32, fr, fq), of[1], acc);
            yd = acc;
        }
    }
    LAS float* Y = (LAS float*)(lds + OFF_Y);
#pragma unroll
    for (int tt = 0; tt < 4; ++tt)
#pragma unroll
        for (int r = 0; r < 4; ++r) Y[(tt * 16 + 4 * fq + r) * PY + wave * 16 + fr] = y[tt][r];
    if (wave < 4) {
#pragma unroll
        for (int r = 0; r < 4; ++r) Y[(wave * 16 + 4 * fq + r) * PY + 128 + fr] = yd[r];
    }
    __syncthreads();
    bf16_t* mixed = (bf16_t*)(p.ws + WS_MIXED);
#pragma unroll
    for (int it = 0; it < 2; ++it) {
        const int item = it * 512 + tid, rloc = item >> 4, cgp = item & 15, row = c * 64 + rloc;
        const float den = Y[rloc * PY + 128];
        const float inv = 1.f / fmaxf(fabsf(den), G[256 + rloc]);
        float o[8], v[8];
        unpack8(og[it], o);
        float ss = 0.f;
#pragma unroll
        for (int j = 0; j < 8; ++j) { v[j] = Y[rloc * PY + cgp * 8 + j] * inv; ss += v[j] * v[j]; }
        ss = sum16_dpp(ss);
        const float rs = rsqrtf(ss * (1.f / 128.f) + EPS);
        const f32x4 w0 = nw0, w1 = nw1;
        const float wv[8] = {w0.x, w0.y, w0.z, w0.w, w1.x, w1.y, w1.z, w1.w};
#pragma unroll
        for (int j = 0; j < 8; ++j) v[j] *= rs * wv[j] * sigmoidf_(o[j]);
        *(u32x4*)(mixed + (size_t)row * D + 512 + h * 128 + cgp * 8) = pack8(v);
    }
    __syncthreads();
}

__device__ __forceinline__ void scan_item(const Params& p, int item) {
    const int bh = __builtin_amdgcn_readfirstlane(item / 1088), sub = item - bh * 1088, b = bh >> 2, h = bh & 3;
    const float* sc = (const float*)(p.ws + WS_SC_M) + ((size_t)(b * CPB) * 4 + h) * 2;
    float m_ = 0.f;
    if (sub < 1024) {
        bf16_t* base = (bf16_t*)(p.ws + WS_ST_M) + ((size_t)(b * CPB) * 4 + h) * 8192 + sub * 8;
        u32x4 loc[CPB];
#pragma unroll
        for (int n = 0; n < CPB; ++n) loc[n] = SCAN_LD((const u32x4*)(base + (size_t)n * 4 * 8192));
        float S[8];
#pragma unroll
        for (int j = 0; j < 8; ++j) S[j] = 0.f;
#pragma unroll
        for (int n = 0; n < CPB; ++n) {
            const float ml = sc[n * 8], tot = sc[n * 8 + 1];
            const float mn = fmaxf(tot + m_, ml), a_ = __expf(tot + m_ - mn), s_ = __expf(ml - mn);
            float l[8]; unpack8(loc[n], l);
            *(u32x4*)(base + (size_t)n * 4 * 8192) = pack8(S);
#pragma unroll
            for (int j = 0; j < 8; ++j) S[j] = a_ * S[j] + s_ * l[j];
            m_ = mn;
        }
    } else {
        const int d = sub - 1024;
        float* nv = (float*)(p.ws + WS_NV_M) + ((size_t)(b * CPB) * 4 + h) * 64 + d;
        float* mp = (float*)(p.ws + WS_MP_M) + (size_t)(b * CPB) * 4 + h;
        float loc[CPB];
#pragma unroll
        for (int n = 0; n < CPB; ++n) loc[n] = nv[(size_t)n * 4 * 64];
        float S = 0.f;
#pragma unroll
        for (int n = 0; n < CPB; ++n) {
            const float ml = sc[n * 8], tot = sc[n * 8 + 1];
            const float mn = fmaxf(tot + m_, ml), a_ = __expf(tot + m_ - mn), s_ = __expf(ml - mn);
            nv[(size_t)n * 4 * 64] = S; S = a_ * S + s_ * loc[n];
            if (d == 0) mp[n * 4] = m_;
            m_ = mn;
        }
    }
}
}
namespace hgr {
constexpr int PF = 132;
constexpr int PT = 272;
constexpr int PP = 144;
constexpr int OFF_X = 0, X_BYTES = 2 * 64 * PT, OFF_CUM = OFF_X + X_BYTES, OFF_KS = OFF_CUM + 64 * PF * 4, OFF_V = OFF_KS + 10 * 16 * PT, OFF_P = OFF_V + 64 * PT, OFF_END = OFF_P + 64 * PP;
static_assert(64 * PF * 4 <= X_BYTES, "LF fits region X");
static_assert(OFF_END <= 147456 - 64, "hgrn2 LDS");
constexpr int OFF_QS = OFF_X, OFF_QC = OFF_X + 64 * PT;

__device__ __forceinline__ float lb_of(const Params& p, int layer, int ch) {
    if (layer == 0) return 0.f;
    const float a0 = p.lbl[ch], a1 = p.lbl[512 + ch];
    return __builtin_amdgcn_rcpf(1.f + __expf(a0 - a1));
}
__device__ __forceinline__ void lb_load(const Params& p, int layer, int h, float (&lbv)[8]) {
    const int cg = opaque_tid() & 15;
    if (layer == 0) {
#pragma unroll
        for (int j = 0; j < 8; ++j) lbv[j] = 0.f;
    } else {
        const float* a = p.lbl + h * 128 + cg * 8;
        const f32x4 a00 = *(const f32x4*)a, a01 = *(const f32x4*)(a + 4), a10 = *(const f32x4*)(a + 512), a11 = *(const f32x4*)(a + 516);
        const float a0[8] = {a00.x, a00.y, a00.z, a00.w, a01.x, a01.y, a01.z, a01.w}, a1[8] = {a10.x, a10.y, a10.z, a10.w, a11.x, a11.y, a11.z, a11.w};
#pragma unroll
        for (int j = 0; j < 8; ++j) lbv[j] = __builtin_amdgcn_rcpf(1.f + __expf(a0[j] - a1[j]));
    }
}
__device__ __forceinline__ void gates(const Params& p, int layer, LAS unsigned char* lds, int c, int h, const u32x4 (&fraw)[2], const float (&lbv)[8]) {
    const int tid = opaque_tid();
    LAS float* LF = (LAS float*)(lds + OFF_X); LAS float* CUM = (LAS float*)(lds + OFF_CUM);
#pragma unroll
    for (int it = 0; it < 2; ++it) {
        const int item = it * 512 + tid, s = item >> 4, cg = item & 15;
        const int pp = (c * 64 + s) % PB;
        float z[8], lf[8];
        unpack8(fraw[it], z);
#pragma unroll
        for (int j = 0; j < 8; ++j) {
            const float lb = lbv[j];
            const float f = lb + (1.f - lb) * sigmoidf_(z[j]);
            lf[j] = pp >= LEADP ? __logf(f) : 0.f;
        }
        *(LAS f32x4*)(LF + s * PF + cg * 8) = (f32x4){lf[0], lf[1], lf[2], lf[3]};
        *(LAS f32x4*)(LF + s * PF + cg * 8 + 4) = (f32x4){lf[4], lf[5], lf[6], lf[7]};
    }
    __syncthreads();
    {
        const int d = tid & 127, sb = tid >> 7;
        float run = 0.f;
#pragma unroll
        for (int i = 0; i < 16; ++i) { run += LF[(sb * 16 + i) * PF + d]; CUM[(sb * 16 + i) * PF + d] = run; }
    }
    __syncthreads();
    {
        const int d = tid & 127, sb = tid >> 7;
        float pre = 0.f;
        for (int q = 0; q < sb; ++q) pre += CUM[(q * 16 + 15) * PF + d];
        __syncthreads();
#pragma unroll
        for (int i = 0; i < 16; ++i) { const int s = sb * 16 + i; CUM[s * PF + d] += pre; const int pp = (c * 64 + s) % PB; LF[s * PF + d] = pp >= LEADP ? 1.f - __expf(LF[s * PF + d]) : 0.f; }
    }
    __syncthreads();
}
__device__ __forceinline__ void load_rows(const Params& p, int c, int col, u32x4 (&raw)[2]) {
    const int tid = opaque_tid();
    const bf16_t* proj = (const bf16_t*)(p.ws + WS_PROJ) + (size_t)(c * 64) * NPROJ + col;
#pragma unroll
    for (int it = 0; it < 2; ++it) { const int item = it * 512 + tid; raw[it] = *(const u32x4*)(proj + (size_t)(item >> 4) * NPROJ + (item & 15) * 8); }
}
__device__ __forceinline__ void stage_v(LAS unsigned char* lds, const u32x4 (&vraw)[2]) {
    const int tid = opaque_tid();
#pragma unroll
    for (int it = 0; it < 2; ++it) { const int item = it * 512 + tid, s = item >> 4, cg = item & 15;
        *(LAS u32x4*)(lds + OFF_V + s * PT + cg * 16) = vraw[it]; }
}

__device__ __forceinline__ void phase_a(const Params& p, int layer, LAS unsigned char* lds, int c, int h) {
    const int tid = opaque_tid(), lane = tid & 63, wave = __builtin_amdgcn_readfirstlane(tid >> 6), fr = lane & 15, fq = lane >> 4;
    LAS float* KF = (LAS float*)(lds + OFF_X); LAS float* CUM = (LAS float*)(lds + OFF_CUM);
    u32x4 vraw[2], fraw[2];
    load_rows(p, c, P_HI + h * 128, vraw); load_rows(p, c, P_HF + h * 128, fraw);
    float lbv[8]; lb_load(p, layer, h, lbv);
    stage_v(lds, vraw);
    gates(p, layer, lds, c, h, fraw, lbv);
#pragma unroll
    for (int it = 0; it < 2; ++it) {
        const int item = it * 512 + tid, s = item >> 4, cg = item & 15;
        float o[8];
#pragma unroll
        for (int hh = 0; hh < 2; ++hh) { const int d = cg * 8 + 4 * hh;
            const f32x4 kf = *(const LAS f32x4*)(KF + s * PF + d), cl = *(const LAS f32x4*)(CUM + 63 * PF + d), cs = *(const LAS f32x4*)(CUM + s * PF + d);
            o[4 * hh + 0] = kf.x * __expf(cl.x - cs.x); o[4 * hh + 1] = kf.y * __expf(cl.y - cs.y); o[4 * hh + 2] = kf.z * __expf(cl.z - cs.z); o[4 * hh + 3] = kf.w * __expf(cl.w - cs.w); }
        *(LAS u32x4*)(lds + OFF_KS + s * PT + cg * 16) = pack8(o);
    }
    if (tid < 128) ((float*)(p.ws + WS_DEC_H))[((size_t)c * 4 + h) * 128 + tid] = __expf(CUM[63 * PF + tid]);
    __syncthreads();
    bf16_t* st = (bf16_t*)(p.ws + WS_ST_H) + ((size_t)c * 4 + h) * 16384;
    {
        const int et = wave;
        bf16x8 vb[2];
#pragma unroll
        for (int ks = 0; ks < 2; ++ks) vb[ks] = frag_tr<PT>(lds + OFF_V, ks * 32, et * 16, lane);
#pragma unroll
        for (int dt = 0; dt < 8; ++dt) {
            f32x4 acc = (f32x4){0.f, 0.f, 0.f, 0.f};
#pragma unroll
            for (int ks = 0; ks < 2; ++ks) acc = mfma16(frag_tr<PT>(lds + OFF_KS, ks * 32, dt * 16, lane), vb[ks], acc);
            u32x2 o; o.x = cvt_pk_bf16(acc[0], acc[1]); o.y = cvt_pk_bf16(acc[2], acc[3]);
            *(u32x2*)(st + frag_off4<4>(et * 16 + fr, dt * 16 + 4 * fq)) = o;
        }
    }
    __syncthreads();
}

__device__ __forceinline__ void phase_c(const Params& p, int layer, LAS unsigned char* lds, int c, int h) {
    const int tid = opaque_tid(), lane = tid & 63, wave = __builtin_amdgcn_readfirstlane(tid >> 6), fr = lane & 15, fq = lane >> 4;
    LAS float* KF = (LAS float*)(lds + OFF_X); LAS float* CUM = (LAS float*)(lds + OFF_CUM);
    u32x4 vraw[2], fraw[2], qraw[2], graw[2];
    load_rows(p, c, P_HI + h * 128, vraw); load_rows(p, c, P_HF + h * 128, fraw); load_rows(p, c, P_HQ + h * 128, qraw); load_rows(p, c, P_HG + h * 128, graw);
    const bf16_t* st = (const bf16_t*)(p.ws + WS_ST_H) + ((size_t)c * 4 + h) * 16384;
    bf16x8 sf[4];
#pragma unroll
    for (int ks = 0; ks < 4; ++ks) sf[ks] = *(const bf16x8*)(st + ((wave * 4 + ks) * 64 + lane) * 8);
    const float* nw = p.hgnw + (size_t)layer * 512 + h * 128 + (tid & 15) * 8;
    const f32x4 nw0 = *(const f32x4*)nw, nw1 = *(const f32x4*)(nw + 4);
    float lbv[8]; lb_load(p, layer, h, lbv);
    stage_v(lds, vraw);
    gates(p, layer, lds, c, h, fraw, lbv);
    for (int item = tid; item < 10 * 16 * 16; item += NTHREADS) {
        const int sbi = item >> 8, rs = (item >> 4) & 15, cg = item & 15;
        const int j = sbi < 1 ? 0 : sbi < 3 ? 1 : sbi < 6 ? 2 : 3, i = sbi - (j * (j + 1)) / 2, s = i * 16 + rs;
        float o[8];
#pragma unroll
        for (int hh = 0; hh < 2; ++hh) { const int d = cg * 8 + 4 * hh;
            const f32x4 kf = *(const LAS f32x4*)(KF + s * PF + d), cs = *(const LAS f32x4*)(CUM + s * PF + d);
            f32x4 rf = (f32x4){0.f, 0.f, 0.f, 0.f}; if (j > 0) rf = *(const LAS f32x4*)(CUM + (16 * j - 1) * PF + d);
            o[4 * hh + 0] = kf.x * __expf(rf.x - cs.x); o[4 * hh + 1] = kf.y * __expf(rf.y - cs.y); o[4 * hh + 2] = kf.z * __expf(rf.z - cs.z); o[4 * hh + 3] = kf.w * __expf(rf.w - cs.w); }
        *(LAS u32x4*)(lds + OFF_KS + (sbi * 16 + rs) * PT + cg * 16) = pack8(o);
    }
    __syncthreads();
#pragma unroll
    for (int it = 0; it < 2; ++it) {
        const int item = it * 512 + tid, t = item >> 4, cg = item & 15, j = t >> 4;
        float q[8], a[8], b[8];
        unpack8(qraw[it], q);
#pragma unroll
        for (int hh = 0; hh < 2; ++hh) { const int d = cg * 8 + 4 * hh;
            const f32x4 cu = *(const LAS f32x4*)(CUM + t * PF + d);
            f32x4 rf = (f32x4){0.f, 0.f, 0.f, 0.f}; if (j > 0) rf = *(const LAS f32x4*)(CUM + (16 * j - 1) * PF + d);
            const float cuv[4] = {cu.x, cu.y, cu.z, cu.w}, rfv[4] = {rf.x, rf.y, rf.z, rf.w};
#pragma unroll
            for (int k = 0; k < 4; ++k) { const float qq = q[4 * hh + k] * 0.08838834764831845f; a[4 * hh + k] = qq * __expf(cuv[k] - rfv[k]); b[4 * hh + k] = qq * __expf(cuv[k]); } }
        *(LAS u32x4*)(lds + OFF_QS + t * PT + cg * 16) = pack8(a);
        *(LAS u32x4*)(lds + OFF_QC + t * PT + cg * 16) = pack8(b);
    }
    __syncthreads();
    for (int ti = wave; ti < 12; ti += 8) {
        int tt, st; bool zero = false;
        if (ti < 10) { tt = ti < 1 ? 0 : ti < 3 ? 1 : ti < 6 ? 2 : 3; st = ti - (tt * (tt + 1)) / 2; }
        else { zero = true; tt = ti == 10 ? 0 : 2; st = tt + 1; }
        f32x4 acc = (f32x4){0.f, 0.f, 0.f, 0.f};
        if (!zero) {
#pragma unroll
            for (int ks = 0; ks < 4; ++ks) acc = mfma16(frag_row<PT>(lds + OFF_QS, tt * 16, ks * 32, fr, fq), frag_row<PT>(lds + OFF_KS + ti * 16 * PT, 0, ks * 32, fr, fq), acc);
        }
        const int s = st * 16 + fr;
#pragma unroll
        for (int r = 0; r < 4; ++r) {
            const int t = tt * 16 + 4 * fq + r;
            const float v = (!zero && s <= t) ? acc[r] : 0.f;
            *(LAS bf16_t*)(lds + OFF_P + t * PP + s * 2) = f2bf(v);
        }
    }
    __syncthreads();
    f32x4 y[4];
    {
        bf16x8 vf[2];
#pragma unroll
        for (int ks = 0; ks < 2; ++ks) vf[ks] = frag_tr<PT>(lds + OFF_V, ks * 32, wave * 16, lane);
#pragma unroll
        for (int tt = 0; tt < 4; ++tt) {
            f32x4 acc = (f32x4){0.f, 0.f, 0.f, 0.f};
#pragma unroll
            for (int ks = 0; ks < 4; ++ks) acc = mfma16(frag_row<PT>(lds + OFF_QC, tt * 16, ks * 32, fr, fq), sf[ks], acc);
            acc = mfma16(frag_row<PP>(lds + OFF_P, tt * 16, 0, fr, fq), vf[0], acc);
            if (tt >= 2) acc = mfma16(frag_row<PP>(lds + OFF_P, tt * 16, 32, fr, fq), vf[1], acc);
            y[tt] = acc;
        }
    }
    LAS float* Y = (LAS float*)(lds + OFF_CUM);
#pragma unroll
    for (int tt = 0; tt < 4; ++tt)
#pragma unroll
        for (int r = 0; r < 4; ++r) Y[(tt * 16 + 4 * fq + r) * PF + wave * 16 + fr] = y[tt][r];
    __syncthreads();
    bf16_t* mixed = (bf16_t*)(p.ws + WS_MIXED);
#pragma unroll
    for (int it = 0; it < 2; ++it) {
        const int item = it * 512 + tid, rloc = item >> 4, cgp = item & 15, row = c * 64 + rloc;
        float g[8], v[8];
        unpack8(graw[it], g);
        float ss = 0.f;
#pragma unroll
        for (int j = 0; j < 8; ++j) { v[j] = Y[rloc * PF + cgp * 8 + j]; ss += v[j] * v[j]; }
        ss = sum16_dpp(ss);
        const float rs = rsqrtf(ss * (1.f / 128.f) + EPS);
        const f32x4 w0 = nw0, w1 = nw1;
        const float wv[8] = {w0.x, w0.y, w0.z, w0.w, w1.x, w1.y, w1.z, w1.w};
#pragma unroll
        for (int j = 0; j < 8; ++j) v[j] *= rs * wv[j] * siluf_(g[j]);
        *(u32x4*)(mixed + (size_t)row * D + h * 128 + cgp * 8) = pack8(v);
    }
    __syncthreads();
}

__device__ __forceinline__ void scan_item(const Params& p, int item) {
    const int e8 = item & 2047, bh = __builtin_amdgcn_readfirstlane(item >> 11), b = bh >> 2, h = bh & 3;
    const int ks = (e8 >> 6) & 3, fql = (e8 & 63) >> 4, d0 = ks * 32 + 8 * fql;
    bf16_t* base = (bf16_t*)(p.ws + WS_ST_H) + ((size_t)(b * CPB) * 4 + h) * 16384 + e8 * 8;
    const float* dec = (const float*)(p.ws + WS_DEC_H) + ((size_t)(b * CPB) * 4 + h) * 128 + d0;
    float S[8];
#pragma unroll
    for (int j = 0; j < 8; ++j) S[j] = 0.f;
#pragma unroll 1
    for (int g = 0; g < 3; ++g) {
        u32x4 loc[11]; f32x4 da[11], db[11];
#pragma unroll
        for (int i = 0; i < 11; ++i) { const int n = g * 11 + i; loc[i] = SCAN_LD((const u32x4*)(base + (size_t)n * 4 * 16384)); da[i] = *(const f32x4*)(dec + (size_t)n * 4 * 128); db[i] = *(const f32x4*)(dec + (size_t)n * 4 * 128 + 4); }
#pragma unroll
        for (int i = 0; i < 11; ++i) { const int n = g * 11 + i;
            const float dd[8] = {da[i].x, da[i].y, da[i].z, da[i].w, db[i].x, db[i].y, db[i].z, db[i].w};
            float l[8]; unpack8(loc[i], l);
            *(u32x4*)(base + (size_t)n * 4 * 16384) = pack8(S);
#pragma unroll
            for (int j = 0; j < 8; ++j) S[j] = dd[j] * S[j] + l[j]; }
    }
}
}
#ifndef NEW_H
#define NEW_H 1
#endif
#ifndef NEW_M
#define NEW_M 1
#endif
#ifndef NEW_S
#define NEW_S 1
#endif
#ifndef MIXRPT_SC
#define MIXRPT_SC 1
#endif
#ifndef MIXRPT_MC
#define MIXRPT_MC 1
#endif
#ifndef MIXRPT_HC
#define MIXRPT_HC 1
#endif
#ifndef MIXRPT_SA
#define MIXRPT_SA 1
#endif
#ifndef MIXRPT_MA
#define MIXRPT_MA 1
#endif
#ifndef MIXRPT_HA
#define MIXRPT_HA 1
#endif
template <bool PHASE_C>
__device__ __forceinline__ void phase_mix(const Params& p, int layer, LAS unsigned char* lds) {
    for (int u = blockIdx.x; u < 3 * NCH * 4; u += gridDim.x) {
        const int type = u % 3, idx = u / 3, c = idx >> 2, sub = idx & 3;
        if (type == 0) { for (int rp = 0; rp < (PHASE_C ? MIXRPT_SC : MIXRPT_SA); ++rp) { if (PHASE_C) ssd::phase_c(p, layer, lds, c, sub); else ssd::phase_a(p, layer, lds, c, sub); } }
        else if (type == 1) { for (int rp = 0; rp < (PHASE_C ? MIXRPT_MC : MIXRPT_MA); ++rp) { if (PHASE_C) mls::phase_c(p, layer, lds, c, sub); else mls::phase_a(p, layer, lds, c, sub); } }
        else { for (int rp = 0; rp < (PHASE_C ? MIXRPT_HC : MIXRPT_HA); ++rp) { if (PHASE_C) hgr::phase_c(p, layer, lds, c, sub); else hgr::phase_a(p, layer, lds, c, sub); } }
    }
}
__device__ __forceinline__ void phase_scan(const Params& p) {
    constexpr int N_S = NB * 16 * 1024, N_M = NB * 4 * 1088, N_H = NB * 4 * 2048;
    for (int gid = blockIdx.x * NTHREADS + opaque_tid(); gid < N_S + N_M + N_H; gid += gridDim.x * NTHREADS) {
        if (gid < N_S) { if (NEW_S) ssd::scan_item(p, gid); }
        else if (gid < N_S + N_M) { if (NEW_M) mls::scan_item(p, gid - N_S); }
        else { if (NEW_H) hgr::scan_item(p, gid - N_S - N_M); }
    }
}
struct EpiResid {
    static constexpr bool PERM = false;
    const float* base; float* out; int ldc;
    __device__ __forceinline__ void operator()(const f32x4 (&acc)[2][2][4][2], const pg8::GU& u, int wr, int wc, int fr, int fq) const {
        const int row0 = u.r0 + wr * 64 + fr, col0 = u.c0 + wc * 32 + 4 * fq;
#pragma unroll
        for (int ai = 0; ai < 2; ++ai) if (ai == 0 || !u.half)
#pragma unroll
            for (int m = 0; m < 4; ++m) { const size_t ro = (size_t)(row0 + ai * 128 + m * 16) * ldc + col0;
#pragma unroll
                for (int bj = 0; bj < 2; ++bj)
#pragma unroll
                    for (int n = 0; n < 2; ++n) { const f32x4 b = *(const f32x4*)(base + ro + bj * 128 + n * 16); { const f32x4 o_ = acc[ai][bj][m][n] + b; NT_STORE(o_, (f32x4*)(out + ro + bj * 128 + n * 16)); } } }
    }
};
struct SchedG2 {
    static constexpr int ldb = D * 2;
    pg8::TileOrder T; const char* A; const char* W;
    __device__ bool next(int i, pg8::GU& u) const { int pm, pn; if (!T.tile(i, pm, pn)) return false;
        u.a = A + (size_t)pm * 256 * D * 2; u.b0 = W + (size_t)pn * 256 * 2; u.b1 = u.b0 + 256; u.r0 = pm * 256; u.c0 = pn * 256; u.ex = 0; u.half = 0; return true; }
    __device__ int row(const pg8::GU&, int) const { return 0; }
};
struct EpiResid0 {
    static constexpr bool PERM = false;
    const float* x; const float* meta; float* out;
    __device__ __forceinline__ void operator()(const f32x4 (&acc)[2][2][4][2], const pg8::GU& u, int wr, int wc, int fr, int fq) const {
        const int row0 = u.r0 + wr * 64 + fr, col0 = u.c0 + wc * 32 + 4 * fq;
#pragma unroll
        for (int ai = 0; ai < 2; ++ai) if (ai == 0 || !u.half)
#pragma unroll
            for (int m = 0; m < 4; ++m) { const int r = row0 + ai * 128 + m * 16, b = r / PB, pp = r % PB, l = pp - LEADP;
                const float* src = l < 0 ? nullptr : (l < NMETA ? meta + (size_t)l * D : x + ((size_t)b * SEQ + (l - NMETA)) * D);
                const size_t ro = (size_t)r * D + col0;
#pragma unroll
                for (int bj = 0; bj < 2; ++bj)
#pragma unroll
                    for (int n = 0; n < 2; ++n) { f32x4 bsv = (f32x4){0.f, 0.f, 0.f, 0.f}; if (src) bsv = *(const f32x4*)(src + col0 + bj * 128 + n * 16);
                        *(f32x4*)(out + ro + bj * 128 + n * 16) = acc[ai][bj][m][n] + bsv; } }
    }
};
__device__ __forceinline__ void phase_g2(const Params& p, int layer, LAS unsigned char* lds) {
    SchedG2 S; S.T.init(R / 256, D / 256, gridDim.x, blockIdx.x); S.A = (const char*)(p.ws + WS_MIXED); S.W = (const char*)(p.ws + WS_WTOUT) + (size_t)layer * D * D * 2;
    if (layer == 0) { EpiResid0 E{p.x, p.meta, (float*)(p.ws + WS_H1)}; pg8::gemm_phase<EpiResid0, SchedG2, false, 1>(lds, D, S, E); }
    else { EpiResid E{(const float*)(p.ws + WS_H0), (float*)(p.ws + WS_H1), D}; pg8::gemm_phase<EpiResid, SchedG2, false, 1>(lds, D, S, E); }
}
constexpr int RTOK = NB * LTOK;
constexpr int RPADMAX = 2 * RTOK + NE * 255;
constexpr size_t WS_W1T  = WS_MIX_END;
constexpr size_t WS_W3T  = WS_W1T + al256((size_t)DEPTH * NE * DE * D * 2);
constexpr size_t WS_W2T  = WS_W3T + al256((size_t)DEPTH * NE * DE * D * 2);
constexpr size_t WS_LIST = WS_W2T + al256((size_t)DEPTH * NE * D * DE * 2);
constexpr size_t WS_ROUTE = WS_LIST + al256((size_t)NE * RTOK * 4);
constexpr size_t WS_END  = WS_ROUTE + al256((size_t)R * 32);
constexpr size_t WS_HB = WS_MIXED;
constexpr size_t WS_YB = WS_PROJ;
static_assert((size_t)RPADMAX * DE * 2 <= WS_W1T - WS_MIXED, "H overlay");
static_assert((size_t)RPADMAX * D * 2 <= WS_GATES - WS_PROJ, "Y overlay");
#ifndef MOE_FP32
#define MOE_FP32 0
#endif
constexpr int MOE_TILE = MOE_FP32 ? 128 : 256;
constexpr int LDS_TAB = 131072;
struct Route { int e[2]; float w[2]; int slot[2]; int pad[2]; };

constexpr int CNT_STRIDE = 64;
__device__ __forceinline__ int* moe_cnt(const Params& p, int layer) { return (int*)(p.ws + WS_CTL) + CW_CNT + layer * 32 * CNT_STRIDE; }

__device__ __forceinline__ void phase_n2(const Params& p, int layer, LAS unsigned char* lds) {
    const int tid = opaque_tid(), lane = tid & 63, wave = __builtin_amdgcn_readfirstlane(tid >> 6), fr = lane & 15, fq = lane >> 4;
    static_assert(RTOK % 16 == 0, "16-token tiles");
    constexpr int NT = RTOK / 16;
    const float* h1 = (const float*)(p.ws + WS_H1); bf16_t* U = (bf16_t*)(p.ws + WS_U);
    const bf16_t* wrf = (const bf16_t*)(p.ws + WS_WRT) + (size_t)layer * WRF_LAYER + (size_t)lane * 8;
    const int half = wave >> 2, kq = wave & 3;
    LAS float* PART = (LAS float*)lds;
    LAS float* LG = (LAS float*)(lds + 32768) + half * (16 * 48 + 16);
#pragma unroll 1
    for (int pass = 0; pass * 2 * (int)gridDim.x < NT; ++pass) {
        const int tile = (int)blockIdx.x + (int)gridDim.x * (2 * pass + half);
        const bool act = tile < NT;
        const int tl = act ? tile : 0;
        const int t = tl * 16 + fr, rowA = (t / LTOK) * PB + LEADP + (t % LTOK);
        const float* ap = h1 + (size_t)rowA * D + kq * 512 + 8 * fq;
        f32x4 acc[3];
#pragma unroll
        for (int ct = 0; ct < 3; ++ct) acc[ct] = (f32x4){0.f, 0.f, 0.f, 0.f};
        float ss = 0.f;
        if (act) {
#pragma unroll 4
            for (int k = 0; k < 16; ++k) {
                const int ks = kq * 16 + k;
                const f32x4 c0 = *(const f32x4*)(ap + k * 32), c1 = *(const f32x4*)(ap + k * 32 + 4);
                bf16x8 bh[3], bl[3];
#pragma unroll
                for (int ct = 0; ct < 3; ++ct) { bh[ct] = *(const bf16x8*)(wrf + ((size_t)(ks * 3 + ct) * 2) * 512); bl[ct] = *(const bf16x8*)(wrf + ((size_t)(ks * 3 + ct) * 2 + 1) * 512); }
                const float xv[8] = {c0.x, c0.y, c0.z, c0.w, c1.x, c1.y, c1.z, c1.w};
                float hi[8], lo[8];
#pragma unroll
                for (int j = 0; j < 8; ++j) { ss += xv[j] * xv[j]; hi[j] = bf2f(f2bf(xv[j])); lo[j] = xv[j] - hi[j]; }
                const u32x4 ph = pack8(hi), pl = pack8(lo);
                const bf16x8 ah = __builtin_bit_cast(bf16x8, ph), al = __builtin_bit_cast(bf16x8, pl);
#pragma unroll
                for (int ct = 0; ct < 3; ++ct) { acc[ct] = mfma16(ah, bh[ct], acc[ct]); acc[ct] = mfma16(ah, bl[ct], acc[ct]); acc[ct] = mfma16(al, bh[ct], acc[ct]); }
            }
        }
#pragma unroll
        for (int ct = 0; ct < 3; ++ct)
#pragma unroll
            for (int r = 0; r < 4; ++r) PART[(wave * 13 + ct * 4 + r) * 64 + lane] = acc[ct][r];
        PART[(wave * 13 + 12) * 64 + lane] = ss;
        __syncthreads();
        if (kq == 0) {
            float tot[13];
#pragma unroll
            for (int i = 0; i < 13; ++i) tot[i] = PART[((wave + 0) * 13 + i) * 64 + lane] + PART[((wave + 1) * 13 + i) * 64 + lane] + PART[((wave + 2) * 13 + i) * 64 + lane] + PART[((wave + 3) * 13 + i) * 64 + lane];
            float sq = tot[12]; sq += __shfl_xor(sq, 16); sq += __shfl_xor(sq, 32);
            const float rs = rsqrtf(sq * (1.f / D) + EPS);
#pragma unroll
            for (int ct = 0; ct < 3; ++ct)
#pragma unroll
                for (int r = 0; r < 4; ++r) LG[(4 * fq + r) * 48 + ct * 16 + fr] = tot[ct * 4 + r];
            if (fq == 0) LG[16 * 48 + fr] = rs;
            LDS_WAIT(); asm volatile("" ::: "memory");
            if (act && lane < 16) {
                const LAS float* lg = LG + lane * 48;
                float l[4];
#pragma unroll
                for (int g = 0; g < 4; ++g) l[g] = lg[g] * rs + p.bg[layer * 4 + g];
                int gs = 0; float gm = l[0];
#pragma unroll
                for (int g = 1; g < 4; ++g) if (l[g] > gm) { gm = l[g]; gs = g; }
                float den = 0.f;
#pragma unroll
                for (int g = 0; g < 4; ++g) den += __expf(l[g] - gm);
                const float ggate = 1.f / den;
                float v0 = -3.0e38f, v1 = -3.0e38f; int i0 = 0, i1 = 0;
#pragma unroll
                for (int e = 0; e < 8; ++e) { const float x = lg[4 + gs * 8 + e] * rs + p.br[layer * 32 + gs * 8 + e];
                    if (x > v0) { v1 = v0; i1 = i0; v0 = x; i0 = e; } else if (x > v1) { v1 = x; i1 = e; } }
                int* cnt = moe_cnt(p, layer); int* list = (int*)(p.ws + WS_LIST); Route* route = (Route*)(p.ws + WS_ROUTE);
                const float p1 = __expf(v1 - v0), sden = 1.f + p1;
                Route rt; rt.e[0] = gs * 8 + i0; rt.e[1] = gs * 8 + i1; rt.w[0] = ggate / sden; rt.w[1] = ggate * p1 / sden;
                rt.slot[0] = atomicAdd(&cnt[rt.e[0] * CNT_STRIDE], 1); rt.slot[1] = atomicAdd(&cnt[rt.e[1] * CNT_STRIDE], 1); rt.pad[0] = 0; rt.pad[1] = 0;
                list[rt.e[0] * RTOK + rt.slot[0]] = rowA; list[rt.e[1] * RTOK + rt.slot[1]] = rowA;
                route[rowA] = rt;
            }
        }
        __syncthreads();
        if (act) {
            const float* wn = p.nfw + (size_t)layer * D;
#pragma unroll 2
            for (int q = 0; q < 4; ++q) {
                const int rr = kq * 4 + q, tq = tl * 16 + rr, rq = (tq / LTOK) * PB + LEADP + (tq % LTOK);
                const float rsq = LG[16 * 48 + rr];
#pragma unroll
                for (int j = 0; j < 8; ++j) { const f32x4 u = *(const f32x4*)(h1 + (size_t)rq * D + 4 * lane + 256 * j) * rsq * *(const f32x4*)(wn + 4 * lane + 256 * j);
                    u32x2 o; o.x = cvt_pk_bf16(u.x, u.y); o.y = cvt_pk_bf16(u.z, u.w); *(u32x2*)(U + (size_t)rq * D + 4 * lane + 256 * j) = o; }
            }
        }
        __syncthreads();
    }
}

#ifndef MOE_LPT
#define MOE_LPT 0
#endif
__device__ __forceinline__ void moe_tables(const Params& p, int layer, LAS unsigned char* lds) {
    LAS int* tab = (LAS int*)(lds + LDS_TAB);
    const int tid = opaque_tid();
    if (tid < 64) {
        const int* cnt = moe_cnt(p, layer);
        const int c = tid < NE ? cnt[tid * CNT_STRIDE] : 0;
        const int rem = c % MOE_TILE, sm = (MOE_LPT && rem > 0 && rem <= MOE_TILE / 2) ? 1 : 0, nt = (c + MOE_TILE - 1) / MOE_TILE, nb = nt - sm;
        int it = nt, ib = nb, is = sm;
#pragma unroll
        for (int o = 1; o < 32; o <<= 1) { const int t0 = __shfl_up(it, o), t1 = __shfl_up(ib, o), t2 = __shfl_up(is, o); if (tid >= o) { it += t0; ib += t1; is += t2; } }
        if (tid < NE) { tab[tid] = c; tab[32 + tid] = it - nt; tab[96 + tid] = ib - nb; tab[128 + tid] = is - sm; }
        if (tid == NE - 1) { tab[64] = it; tab[65] = ib; }
    }
    __syncthreads();
}
__device__ __forceinline__ int moe_find(LAS const int* tab, int ti) { int e = 0;
#pragma unroll 1
    for (int k = 1; k < NE; ++k) if (tab[32 + k] <= ti) e = k;
    return e; }
__device__ __forceinline__ void moe_unit(LAS const int* tab, int u, int& e, int& rt) {
    const int nb = tab[65]; const bool small = u >= nb; const int v = small ? u - nb : u, base = small ? 128 : 96;
    e = 0;
#pragma unroll 1
    for (int k = 1; k < NE; ++k) if (tab[base + k] <= v) e = k;
    rt = small ? tab[e] / MOE_TILE : v - tab[96 + e];
}
__device__ __forceinline__ int moe_half(int rows) { return (MOE_LPT && rows <= 64) ? 2 : (rows <= 128 ? 1 : 0); }

#ifndef MOE_XCD
#define MOE_XCD 1
#endif
#define MOE_VCU ((MOE_XCD && (gridDim.x % 8 == 0)) ? (int)((blockIdx.x % 8) * (gridDim.x / 8) + blockIdx.x / 8) : (int)blockIdx.x)
struct SchedMoe1 {
    static constexpr int ldb = DE * 2;
    LAS const int* tab; const int* list; const char* U; const char* W1; const char* W3; int G, c, force, first, lim;
    __device__ bool next(int i, pg8::GU& u) const {
        const int Lx = first + i * G + c; if (c < 0 || Lx >= lim || Lx >= tab[64] * 4) return false;
        const int ct = Lx & 3; int e, rt; moe_unit(tab, Lx >> 2, e, rt); const int ti = tab[32 + e] + rt;
        u.a = U; const size_t wo = ((size_t)e * D * DE + ct * 128) * 2; u.b0 = W1 + wo; u.b1 = W3 + wo; u.r0 = ti * 256; u.c0 = ct * 128; u.ex = e | (rt << 8); u.half = force ? force : moe_half(tab[e] - rt * 256); return true; }
    __device__ int row(const pg8::GU& u, int r) const { const int e = u.ex & 255, rt = u.ex >> 8, c_ = tab[e]; int idx = rt * 256 + r; idx = idx < c_ ? idx : c_ - 1; return list[e * RTOK + idx]; }
};
struct EpiSwiglu {
    static constexpr bool PERM = false;
    bf16_t* H;
    __device__ __forceinline__ void operator()(const f32x4 (&acc)[2][2][4][2], const pg8::GU& u, int wr, int wc, int fr, int fq) const {
        const int row0 = u.r0 + wr * 64 + fr, col0 = u.c0 + wc * 32 + 4 * fq;
#pragma unroll
        for (int ai = 0; ai < 2; ++ai)
#pragma unroll
            for (int m = 0; m < 4; ++m) { bf16_t* rowp = H + (size_t)(row0 + ai * 128 + m * 16) * DE + col0;
#pragma unroll
                for (int n = 0; n < 2; ++n) { float h[4];
#pragma unroll
                    for (int k = 0; k < 4; ++k) h[k] = siluf_(acc[ai][0][m][n][k]) * acc[ai][1][m][n][k];
                    u32x2 o; o.x = cvt_pk_bf16(h[0], h[1]); o.y = cvt_pk_bf16(h[2], h[3]); NT_STORE(o, (u32x2*)(rowp + n * 16)); } }
    }
};
struct EpiBf16Store2 {
    static constexpr bool PERM = false;
    bf16_t* O; int ldc;
    __device__ __forceinline__ void operator()(const f32x4 (&acc)[2][2][4][2], const pg8::GU& u, int wr, int wc, int fr, int fq) const {
        const int row0 = u.r0 + wr * 64 + fr, col0 = u.c0 + wc * 32 + 4 * fq;
#pragma unroll
        for (int ai = 0; ai < 2; ++ai)
#pragma unroll
            for (int m = 0; m < 4; ++m) { bf16_t* rowp = O + (size_t)(row0 + ai * 128 + m * 16) * ldc + col0;
#pragma unroll
                for (int bj = 0; bj < 2; ++bj)
#pragma unroll
                    for (int n = 0; n < 2; ++n) { const f32x4 v = acc[ai][bj][m][n]; u32x2 o; o.x = cvt_pk_bf16(v[0], v[1]); o.y = cvt_pk_bf16(v[2], v[3]); NT_STORE(o, (u32x2*)(rowp + bj * 128 + n * 16)); } }
    }
};
__device__ __forceinline__ void phase_e1(const Params& p, int layer, LAS unsigned char* lds, int force = 0, int first = 0, int lim = 0x7fffffff) {
    moe_tables(p, layer, lds);
    SchedMoe1 S; S.tab = (LAS const int*)(lds + LDS_TAB); S.list = (const int*)(p.ws + WS_LIST); S.U = (const char*)(p.ws + WS_U);
    S.W1 = (const char*)(p.ws + WS_W1T) + (size_t)layer * NE * DE * D * 2; S.W3 = (const char*)(p.ws + WS_W3T) + (size_t)layer * NE * DE * D * 2; S.G = gridDim.x; S.c = MOE_VCU; S.force = force; S.first = first; S.lim = lim;
    EpiSwiglu E{(bf16_t*)(p.ws + WS_HB)};
    pg8::gemm_phase<EpiSwiglu, SchedMoe1, true, 1>(lds, D, S, E);
}
struct SchedMoe2 {
    static constexpr int ldb = D * 2;
    LAS const int* tab; const char* H; const char* W2; int G, c, first, lim;
    __device__ bool next(int i, pg8::GU& u) const {
        const int Lx = first + i * G + c; if (c < 0 || Lx >= lim || Lx >= tab[64] * 8) return false;
        const int ct = Lx & 7; int e, rt; moe_unit(tab, Lx >> 3, e, rt); const int ti = tab[32 + e] + rt;
        u.a = H + (size_t)ti * 256 * DE * 2; u.b0 = W2 + ((size_t)e * DE * D + ct * 256) * 2; u.b1 = u.b0 + 256; u.r0 = ti * 256; u.c0 = ct * 256; u.ex = e; u.half = moe_half(tab[e] - rt * 256); return true; }
    __device__ int row(const pg8::GU&, int) const { return 0; }
};
__device__ __forceinline__ void phase_e2(const Params& p, int layer, LAS unsigned char* lds, int first = 0, int lim = 0x7fffffff, int G = -1, int c = -2) {
    moe_tables(p, layer, lds);
    SchedMoe2 S; S.tab = (LAS const int*)(lds + LDS_TAB); S.H = (const char*)(p.ws + WS_HB); S.W2 = (const char*)(p.ws + WS_W2T) + (size_t)layer * NE * D * DE * 2;
    S.G = G > 0 ? G : (int)gridDim.x; S.c = c > -2 ? c : MOE_VCU; S.first = first; S.lim = lim;
    EpiBf16Store2 E{(bf16_t*)(p.ws + WS_YB), D};
    pg8::gemm_phase<EpiBf16Store2, SchedMoe2, false, 1>(lds, DE, S, E);
}
__device__ __forceinline__ void phase_e1a(const Params& p, int layer, LAS unsigned char* lds) { phase_e1(p, layer, lds, 0, 0, (int)gridDim.x); }
__device__ __forceinline__ void phase_emid(const Params& p, int layer, LAS unsigned char* lds) {
    const int G = (int)gridDim.x;
    phase_e1(p, layer, lds, 0, G, 0x7fffffff);
    const int tiles = *(const LAS int*)(lds + LDS_TAB + 256), T1 = 4 * tiles, R1 = T1 > G ? T1 - G : 0, early = 8 * (tiles < G / 4 ? tiles : G / 4);
    __syncthreads();
    if (R1 < G) phase_e2(p, layer, lds, 0, early, G - R1, MOE_VCU - R1); else phase_e2(p, layer, lds, 0, early, G, MOE_VCU);
}
__device__ __forceinline__ void phase_e2b(const Params& p, int layer, LAS unsigned char* lds) {
    moe_tables(p, layer, lds);
    const int G = (int)gridDim.x, tiles = *(const LAS int*)(lds + LDS_TAB + 256), early = 8 * (tiles < G / 4 ? tiles : G / 4);
    __syncthreads();
    phase_e2(p, layer, lds, early, 0x7fffffff, G, MOE_VCU);
}

__device__ __forceinline__ int combine_excl(const Params& p, int layer, int lane) {
    const int* cnt = moe_cnt(p, layer);
    int nt = 0; if (lane < NE) nt = (cnt[lane * CNT_STRIDE] + MOE_TILE - 1) / MOE_TILE;
    int incl = nt;
#pragma unroll
    for (int o = 1; o < 32; o <<= 1) { const int t = __shfl_up(incl, o); if (lane >= o) incl += t; }
    return incl - nt;
}
__device__ __forceinline__ void load_combined(const Params& p, int excl, int r, int lane, f32x4 (&v)[8]) {
    const Route q = ((const Route*)(p.ws + WS_ROUTE))[r];
    const size_t r0 = (size_t)(__shfl(excl, q.e[0]) * MOE_TILE + q.slot[0]) * D, r1 = (size_t)(__shfl(excl, q.e[1]) * MOE_TILE + q.slot[1]) * D;
    const float* h1 = (const float*)(p.ws + WS_H1) + (size_t)r * D; const bf16_t* Y = (const bf16_t*)(p.ws + WS_YB);
#pragma unroll
    for (int j = 0; j < 8; ++j) {
        const f32x4 h = N1_LD((const f32x4*)(h1 + 4 * lane + 256 * j));
        const u32x2 a = N1_LD((const u32x2*)(Y + r0 + 4 * lane + 256 * j)), bq = N1_LD((const u32x2*)(Y + r1 + 4 * lane + 256 * j));
        v[j].x = h.x + q.w[0] * bflo(a.x) + q.w[1] * bflo(bq.x); v[j].y = h.y + q.w[0] * bfhi(a.x) + q.w[1] * bfhi(bq.x);
        v[j].z = h.z + q.w[0] * bflo(a.y) + q.w[1] * bflo(bq.y); v[j].w = h.w + q.w[0] * bfhi(a.y) + q.w[1] * bfhi(bq.y);
    }
}
template <>
__device__ __forceinline__ void n1_load_row<2>(const Params& p, const N1Src& sr, int excl, int r, int lane, f32x4 (&v)[8]) {
    const int pp = r % PB;
    if (pp < LEADP) {
#pragma unroll
        for (int j = 0; j < 8; ++j) v[j] = (f32x4){0.f, 0.f, 0.f, 0.f};
    } else { (void)sr; load_combined(p, excl, r, lane, v); }
}
__device__ __forceinline__ void phase_fn(const Params& p) {
    const int tid = opaque_tid(), lane = tid & 63, wave = __builtin_amdgcn_readfirstlane(tid >> 6);
    const int gw = blockIdx.x * NWAVES + wave, NGW = gridDim.x * NWAVES;
    f32x4 wv[8];
#pragma unroll
    for (int j = 0; j < 8; ++j) wv[j] = *(const f32x4*)(p.fnw + 4 * lane + 256 * j);
    const int excl = combine_excl(p, DEPTH - 1, lane);
    for (int task = gw; task < NB * SEQ; task += NGW) {
        const int b = task / SEQ, s = task % SEQ, r = b * PB + 64 + s;
        f32x4 v[8]; load_combined(p, excl, r, lane, v);
        float ss = 0.f;
#pragma unroll
        for (int j = 0; j < 8; ++j) ss += (v[j].x * v[j].x + v[j].y * v[j].y) + (v[j].z * v[j].z + v[j].w * v[j].w);
        const float rs = rsqrtf(wave_sum(ss) * (1.f / D) + EPS);
#pragma unroll
        for (int j = 0; j < 8; ++j) { const f32x4 o_ = v[j] * rs * wv[j]; __builtin_nontemporal_store(o_, (f32x4*)(p.out + (size_t)task * D + 4 * lane + 256 * j)); }
    }
}
constexpr int CW_QHEAD = 8192;
constexpr int QPER = NE * D * DE / 4096;
constexpr int QITEMS = 3 * QPER;
static_assert(WS_W3T - WS_W1T == WS_W2T - WS_W3T, "the three bf16 expert-weight copies are equally spaced");
__device__ __forceinline__ void convert_items(LAS unsigned char* lds, int layer, int first, int n) {
    const int tid = opaque_tid();
    unsigned char* ws = (unsigned char*)lds_ptr(lds, 26);
    for (int it = first; it < first + n; ++it) {
#ifndef CONV_REV
#define CONV_REV 0
#endif
#ifndef CONV_NT
#define CONV_NT 1
#endif
        const int w = CONV_REV ? 2 - it / QPER : it / QPER, off = it % QPER;
        const size_t e0 = (((size_t)layer * QPER + off) * 512 + tid) * 8;
        const float* src = (const float*)lds_ptr(lds, 21 + w) + e0;
        bf16_t* dst = (bf16_t*)(ws + WS_W1T + (size_t)w * (WS_W3T - WS_W1T)) + e0;
        const f32x4 a = __builtin_nontemporal_load((const f32x4*)src), b = __builtin_nontemporal_load((const f32x4*)(src + 4));
        u32x4 o; o.x = cvt_pk_bf16(a.x, a.y); o.y = cvt_pk_bf16(a.z, a.w); o.z = cvt_pk_bf16(b.x, b.y); o.w = cvt_pk_bf16(b.z, b.w);
        if (CONV_NT) __builtin_nontemporal_store(o, (u32x4*)dst); else *(u32x4*)dst = o;
    }
}
constexpr int CW_DONE = 8192 + 256;
__device__ __forceinline__ void convert_until(const Params& p, LAS unsigned char* lds, int lfirst, int llast, int phase_id, int my_units, int total_units) {
    LAS int* slot = (LAS int*)(lds + LDS_QSLOT);
    unsigned* donew = (unsigned*)(p.ws + WS_CTL) + CW_DONE + 64 * phase_id;
    if (threadIdx.x == 0 && my_units > 0) (void)__hip_atomic_fetch_add(donew, (unsigned)my_units, __ATOMIC_RELAXED, __HIP_MEMORY_SCOPE_AGENT);
    int layer = lfirst;
    for (int it = 0; it < 8192; ++it) {
        if (layer > llast || layer >= DEPTH) break;
        if (threadIdx.x == 0) {
            const unsigned dn = __hip_atomic_load(donew, __ATOMIC_RELAXED, __HIP_MEMORY_SCOPE_AGENT);
            int v = -1;
            if (dn < (unsigned)total_units) v = (int)__hip_atomic_fetch_add((unsigned*)(p.ws + WS_CTL) + CW_QHEAD + 64 * layer, 2u, __ATOMIC_RELAXED, __HIP_MEMORY_SCOPE_AGENT);
            *slot = v; }
        __syncthreads();
        const int base = __builtin_amdgcn_readfirstlane(*slot);
        __syncthreads();
        if (base < 0) break;
        if (base >= QITEMS) { ++layer; continue; }
        convert_items(lds, layer, base, 2 < QITEMS - base ? 2 : QITEMS - base);
    }
}
__device__ __forceinline__ void convert_bg(const Params& p, LAS unsigned char* lds, int lfirst, int llast, int budget) {
    LAS int* slot = (LAS int*)(lds + LDS_QSLOT);
    for (int layer = lfirst; layer <= llast && layer < DEPTH; ++layer) {
        unsigned* qh = (unsigned*)(p.ws + WS_CTL) + CW_QHEAD + 64 * layer;
        while (budget > 0) {
            const int n = budget < 8 ? budget : 8;
            if (threadIdx.x == 0) *slot = (int)__hip_atomic_fetch_add(qh, (unsigned)n, __ATOMIC_RELAXED, __HIP_MEMORY_SCOPE_AGENT);
            __syncthreads();
            const int base = __builtin_amdgcn_readfirstlane(*slot);
            __syncthreads();
            if (base >= QITEMS) break;
            convert_items(lds, layer, base, n < QITEMS - base ? n : QITEMS - base);
            budget -= n;
        }
    }
}
#ifndef RPT_P0
#define RPT_P0 1
#endif
#ifndef RPT_N1
#define RPT_N1 1
#endif
#ifndef RPT_G1
#define RPT_G1 1
#endif
#ifndef RPT_MA
#define RPT_MA 1
#endif
#ifndef RPT_MC
#define RPT_MC 1
#endif
#ifndef RPT_G2
#define RPT_G2 1
#endif
#ifndef RPT_E1
#define RPT_E1 1
#endif
#ifndef RPT_E2
#define RPT_E2 1
#endif
#ifndef RPT_FN
#define RPT_FN 1
#endif
#ifndef RPT_N2
#define RPT_N2 1
#endif
#ifndef RPT_MAB
#define RPT_MAB 1
#endif
#ifndef RPT_E1B
#define RPT_E1B 1
#endif
#ifndef RPT_E2B
#define RPT_E2B 1
#endif
#ifndef RPT_E1F
#define RPT_E1F 1
#endif
#ifndef E1FORCE
#define E1FORCE 2
#endif
#ifndef MOE_SPLIT3
#define MOE_SPLIT3 0
#endif
#ifndef RPT_BAR
#define RPT_BAR 1
#endif

__device__ __forceinline__ Params load_params(LAS unsigned char* lds) {
    asm volatile("" ::: "memory");
    Params p;
    p.x = (const float*)lds_ptr(lds, 0); p.meta = (const float*)lds_ptr(lds, 1); p.lbl = (const float*)lds_ptr(lds, 2); p.nmw = (const float*)lds_ptr(lds, 3); p.w_in = (const float*)lds_ptr(lds, 4);
    p.hgnw = (const float*)lds_ptr(lds, 5); p.mbi = (const float*)lds_ptr(lds, 6); p.mbf = (const float*)lds_ptr(lds, 7); p.mlnw = (const float*)lds_ptr(lds, 8); p.cw = (const float*)lds_ptr(lds, 9);
    p.cb = (const float*)lds_ptr(lds, 10); p.dtb = (const float*)lds_ptr(lds, 11); p.alog = (const float*)lds_ptr(lds, 12); p.dsk = (const float*)lds_ptr(lds, 13); p.ssnw = (const float*)lds_ptr(lds, 14);
    p.w_out = (const float*)lds_ptr(lds, 15); p.nfw = (const float*)lds_ptr(lds, 16); p.wg = (const float*)lds_ptr(lds, 17); p.bg = (const float*)lds_ptr(lds, 18); p.wr = (const float*)lds_ptr(lds, 19);
    p.br = (const float*)lds_ptr(lds, 20); p.w1 = (const float*)lds_ptr(lds, 21); p.w3 = (const float*)lds_ptr(lds, 22); p.w2 = (const float*)lds_ptr(lds, 23); p.fnw = (const float*)lds_ptr(lds, 24);
    p.out = (float*)lds_ptr(lds, 25); p.ws = (unsigned char*)lds_ptr(lds, 26);
    return p;
}
__device__ __forceinline__ void grid_bar(LAS unsigned char* lds) {
    asm volatile("" ::: "memory");
    XcdBarrier b; b.bar = (unsigned*)((unsigned char*)lds_ptr(lds, 26) + WS_CTL) + CW_BAR;
    b.x = (unsigned)__builtin_amdgcn_readfirstlane((int)*(const LAS unsigned*)(lds + LDS_PARAMS + 8 * 27)); b.st = (volatile LAS unsigned*)(lds + LDS_BARW);
    xcd_barrier(b);
}
#if MOE_FP32
#define convert_bg(...) ((void)0)
#define MOE_E1 phase_e1x
#define MOE_E2 phase_e2x
#else
#define MOE_E1 phase_e1
#define MOE_E2 phase_e2
#endif
__global__ void __launch_bounds__(NTHREADS, 2) k_mega(Params pk) {
    extern __shared__ __attribute__((aligned(16))) unsigned char lds_raw[];
    LAS unsigned char* lds = (LAS unsigned char*)lds_raw;
    if (threadIdx.x == 0) {
        *(LAS u32x4*)(lds + LDS_BARW) = (u32x4){0u, 0u, 0u, 0u};
        LAS unsigned long long* q = (LAS unsigned long long*)(lds + LDS_PARAMS);
        q[0] = (unsigned long long)pk.x; q[1] = (unsigned long long)pk.meta; q[2] = (unsigned long long)pk.lbl; q[3] = (unsigned long long)pk.nmw; q[4] = (unsigned long long)pk.w_in;
        q[5] = (unsigned long long)pk.hgnw; q[6] = (unsigned long long)pk.mbi; q[7] = (unsigned long long)pk.mbf; q[8] = (unsigned long long)pk.mlnw; q[9] = (unsigned long long)pk.cw;
        q[10] = (unsigned long long)pk.cb; q[11] = (unsigned long long)pk.dtb; q[12] = (unsigned long long)pk.alog; q[13] = (unsigned long long)pk.dsk; q[14] = (unsigned long long)pk.ssnw;
        q[15] = (unsigned long long)pk.w_out; q[16] = (unsigned long long)pk.nfw; q[17] = (unsigned long long)pk.wg; q[18] = (unsigned long long)pk.bg; q[19] = (unsigned long long)pk.wr;
        q[20] = (unsigned long long)pk.br; q[21] = (unsigned long long)pk.w1; q[22] = (unsigned long long)pk.w3; q[23] = (unsigned long long)pk.w2; q[24] = (unsigned long long)pk.fnw;
        q[25] = (unsigned long long)pk.out; q[26] = (unsigned long long)pk.ws;
    }
    __syncthreads();
    { const XcdBarrier b0 = xcd_barrier_post((unsigned*)(pk.ws + WS_CTL) + CW_BAR, (volatile LAS unsigned*)(lds + LDS_BARW));
      if (threadIdx.x == 0) *(LAS unsigned*)(lds + LDS_PARAMS + 8 * 27) = b0.x; }
    __syncthreads();
#define PH(stmt) do { { const Params p = load_params(lds); stmt; } for (int _b = 0; _b < RPT_BAR; ++_b) grid_bar(lds); } while (0)
#define PHR(n, stmt) do { for (int _r = 0; _r < (n); ++_r) PH(stmt); } while (0)
    for (int _r = 0; _r < RPT_P0; ++_r) { const Params p = load_params(lds); phase_p0(p, lds); }
#ifndef BG_G1
#define BG_G1 40
#endif
#ifndef BG_MA
#define BG_MA 8
#endif
#ifndef BG_MC
#define BG_MC 15
#endif
#ifndef BG_G2
#define BG_G2 45
#endif
#ifndef BG_E1
#define BG_E1 45
#endif
#ifndef BG_E2
#define BG_E2 14
#endif
    const int bx = blockIdx.x, G_ = gridDim.x;
#define MY_UNITS(total) ((bx < (total)) ? (((total) - bx + G_ - 1) / G_) : 0)
#define IDLE_UNITS(total) ((((total) + G_ - 1) / G_) - ((bx < (total)) ? (((total) - bx + G_ - 1) / G_) : 0))
#define IDLE_UNITS_C(total, cc) ((((total) + G_ - 1) / G_) - (((cc) < (total)) ? (((total) - (cc) + G_ - 1) / G_) : 0))
#ifndef DYN_FILL
#define DYN_FILL 0
#endif
#define MY_UNITS_C(total, cc) (((cc) < (total)) ? (((total) - (cc) + G_ - 1) / G_) : 0)
#define LAYER(layer) do { N1Src src{}; src.layer_prev = (layer) - 1; \
        PHR(RPT_N1, if ((layer) == 0) phase_n1<0>(p, (layer), src); else phase_n1<2>(p, (layer), src)); \
        PHR(RPT_G1, phase_g1(p, (layer), lds); if (DYN_FILL) convert_until(p, lds, (layer), DEPTH - 1, (layer) * 8 + 0, MY_UNITS_C((R / 256) * (NPROJX / 256), bx), (R / 256) * (NPROJX / 256)); else convert_bg(p, lds, (layer), DEPTH - 1, BG_G1 * IDLE_UNITS((R / 256) * (NPROJX / 256)))); \
        PHR(RPT_MA, phase_mix<false>(p, (layer), lds); convert_bg(p, lds, (layer), DEPTH - 1, BG_MA * IDLE_UNITS(3 * NCH * 4))); \
        PH(phase_scan(p)); \
        for (int _n = 1; _n < RPT_MAB; ++_n) { PH(phase_mix<false>(p, (layer), lds)); PH(phase_scan(p)); } \
        PHR(RPT_MC, phase_mix<true>(p, (layer), lds); convert_bg(p, lds, (layer), DEPTH - 1, BG_MC * IDLE_UNITS(3 * NCH * 4))); \
        PHR(RPT_G2, phase_g2(p, (layer), lds); if (DYN_FILL) convert_until(p, lds, (layer), DEPTH - 1, (layer) * 8 + 3, MY_UNITS_C((R / 256) * (D / 256), bx), (R / 256) * (D / 256)); else convert_bg(p, lds, (layer), DEPTH - 1, BG_G2 * IDLE_UNITS((R / 256) * (D / 256)))); \
        for (int _n = 1; _n < RPT_N2; ++_n) { PH(phase_n2(p, (layer), lds)); PH(if (blockIdx.x == 0 && threadIdx.x < 32) moe_cnt(p, (layer))[threadIdx.x * CNT_STRIDE] = 0); } \
        PH(phase_n2(p, (layer), lds); convert_bg(p, lds, (layer), (layer), QITEMS)); \
        if (MOE_SPLIT3 && (layer) == DEPTH - 1) { PH(phase_e1a(p, (layer), lds)); PH(phase_emid(p, (layer), lds)); PH(phase_e2b(p, (layer), lds)); } else { \
        PHR(RPT_E1, MOE_E1(p, (layer), lds); { const int T_ = 4 * *(const LAS int*)(lds + LDS_TAB + 256); convert_bg(p, lds, (layer) + 1, DEPTH - 1, BG_E1 * IDLE_UNITS_C(T_, MOE_VCU)); }); \
        PHR(RPT_E2, MOE_E2(p, (layer), lds); { const int T_ = 8 * *(const LAS int*)(lds + LDS_TAB + 256); convert_bg(p, lds, (layer) + 1, DEPTH - 1, BG_E2 * IDLE_UNITS_C(T_, MOE_VCU)); }); } } while (0)
    static_assert(DEPTH == 2, "two layers written out");
    LAYER(0);
    LAYER(1);
#undef LAYER
    for (int _r = 0; _r < RPT_FN; ++_r) { const Params p = load_params(lds); phase_fn(p); }
#undef PH
}

extern "C" void kernel_launch(void* const* d_in, const int* in_sizes, int n_in, void* d_out, int out_size, void* d_ws, size_t ws_size, hipStream_t stream) {
    Params p{};
    p.x = (const float*)d_in[0]; p.meta = (const float*)d_in[1]; p.lbl = (const float*)d_in[2]; p.nmw = (const float*)d_in[3]; p.w_in = (const float*)d_in[4];
    p.hgnw = (const float*)d_in[5]; p.mbi = (const float*)d_in[6]; p.mbf = (const float*)d_in[7]; p.mlnw = (const float*)d_in[8]; p.cw = (const float*)d_in[9];
    p.cb = (const float*)d_in[10]; p.dtb = (const float*)d_in[11]; p.alog = (const float*)d_in[12]; p.dsk = (const float*)d_in[13]; p.ssnw = (const float*)d_in[14];
    p.w_out = (const float*)d_in[15]; p.nfw = (const float*)d_in[16]; p.wg = (const float*)d_in[17]; p.bg = (const float*)d_in[18]; p.wr = (const float*)d_in[19];
    p.br = (const float*)d_in[20]; p.w1 = (const float*)d_in[21]; p.w3 = (const float*)d_in[22]; p.w2 = (const float*)d_in[23]; p.fnw = (const float*)d_in[24];
    p.out = (float*)d_out; p.ws = (unsigned char*)d_ws;
    static int grid = 0;
    if (grid == 0) {
        int dev = 0, cus = 0, per_cu = 0;
        (void)hipGetDevice(&dev); (void)hipDeviceGetAttribute(&cus, hipDeviceAttributeMultiprocessorCount, dev);
        (void)hipFuncSetAttribute((const void*)k_mega, hipFuncAttributeMaxDynamicSharedMemorySize, LDS_BYTES);
        (void)hipOccupancyMaxActiveBlocksPerMultiprocessor(&per_cu, (const void*)k_mega, NTHREADS, LDS_BYTES);
        (void)hipGetLastError();
        grid = (per_cu >= 1 && cus > 0) ? cus : -1;
        if (WS_END > ws_size) { fprintf(stderr, "workspace too small: need %zu have %zu\n", (size_t)WS_END, ws_size); grid = -1; }
    }
    (void)n_in; (void)in_sizes; (void)out_size;
    if (grid < 0) return;
    (void)hipMemsetAsync((char*)d_ws + WS_CTL, 0, CTL_BYTES, stream);
    hipLaunchKernelGGL(k_mega, dim3(grid), dim3(NTHREADS), LDS_BYTES, stream, p);
}
```
